# Optimizing an MI355X kernel written in HIP

```python
import jax, jax.numpy as jnp
from jax import lax
import numpy as np

D_MODEL = 2048
BATCH = 1
SEQ = 8192
DEPTH = 1

M_HEADS = 8
M_DQK = 64
M_DV = 128
M_CONV = 4
M_CHUNK = 64
F_HEADS = 8
F_DH = 128
F_BLOCK = 128
N_EXPERTS = 32
TOP_K = 4
D_FF = 2048
SWIGLU_LIMIT = 7.0
SWIGLU_ALPHA = 1.702
EPS = 1e-6

M_QK_W = M_HEADS * M_DQK
M_V_W = M_HEADS * M_DV
F_W = F_HEADS * F_DH
IN_SIZES = (M_QK_W, M_QK_W, M_V_W, M_HEADS, M_HEADS, M_V_W,
            F_W, F_W, F_W, F_HEADS, F_W, D_MODEL, D_MODEL)
IN_WIDTH = sum(IN_SIZES)

kernel_name = "hybrid_mlstm_fox_moe_adaln"


def rmsnorm(x, g):
    xf = x.astype(jnp.float32)
    y = xf * lax.rsqrt(jnp.mean(xf * xf, axis=-1, keepdims=True) + EPS)
    return (y * g.astype(jnp.float32)).astype(x.dtype)


def causal_dwconv(x, w, b):
    C = x.shape[-1]
    y = lax.conv_general_dilated(x, w[:, None, :].astype(x.dtype), window_strides=(1,),
                                 padding=[(w.shape[0] - 1, 0)],
                                 dimension_numbers=('NWC', 'WIO', 'NWC'),
                                 feature_group_count=C)
    return y + b


def to_heads(a, h):
    B, S, W = a.shape
    return a.reshape(B, S, h, W // h).transpose(0, 2, 1, 3)


def mlstm_chunkwise(q, k, v, i_pre, logf):
    B, H, S, dqk = q.shape
    dv = v.shape[-1]
    L = M_CHUNK
    nc = S // L

    def to_chunks(a):
        return jnp.moveaxis(a.reshape(B, H, nc, L, *a.shape[3:]), 2, 0)

    qc, kc, vc, ic, fc = (to_chunks(a) for a in (q, k * (dqk ** -0.5), v, i_pre, logf))
    causal = jnp.tril(jnp.ones((L, L), bool))

    def step(carry, inp):
        C, n, m = carry
        qb, kb, vb, ib, fb = inp
        b = jnp.cumsum(fb, axis=-1)
        g = b[..., -1]
        dmat = jnp.where(causal, b[..., :, None] - b[..., None, :] + ib[..., None, :], -jnp.inf)
        inter = b + m[..., None]
        m_t = jnp.maximum(inter, jnp.max(dmat, axis=-1))
        w_intra = jnp.exp(dmat - m_t[..., None])
        w_inter = jnp.exp(inter - m_t)
        s = jnp.einsum('bhtd,bhsd->bhts', qb, kb) * w_intra
        num = (jnp.einsum('bhts,bhsv->bhtv', s, vb)
               + w_inter[..., None] * jnp.einsum('bhtd,bhdv->bhtv', qb, C))
        den = jnp.sum(s, axis=-1) + w_inter * jnp.einsum('bhtd,bhd->bht', qb, n)
        h = num / jnp.maximum(jnp.abs(den), jnp.exp(-m_t))[..., None]
        a = g[..., None] - b + ib
        m_new = jnp.maximum(g + m, jnp.max(a, axis=-1))
        wk = jnp.exp(a - m_new[..., None])
        decay = jnp.exp(g + m - m_new)
        C_new = decay[..., None, None] * C + jnp.einsum('bhs,bhsd,bhsv->bhdv', wk, kb, vb)
        n_new = decay[..., None] * n + jnp.einsum('bhs,bhsd->bhd', wk, kb)
        return (C_new, n_new, m_new), h

    init = (jnp.zeros((B, H, dqk, dv), jnp.float32),
            jnp.zeros((B, H, dqk), jnp.float32),
            jnp.zeros((B, H), jnp.float32))
    _, hs = lax.scan(step, init, (qc, kc, vc, ic, fc))
    return jnp.moveaxis(hs, 0, 2).reshape(B, H, S, dv)


def forgetting_attention(q, k, v, logf):
    B, H, S, dh = q.shape
    nb = S // F_BLOCK
    F = jnp.cumsum(logf, axis=-1)
    kpos = jnp.arange(S)
    scale = dh ** -0.5

    def block(i):
        start = i * F_BLOCK
        qb = lax.dynamic_slice_in_dim(q, start, F_BLOCK, axis=2)
        Fb = lax.dynamic_slice_in_dim(F, start, F_BLOCK, axis=2)
        qpos = start + jnp.arange(F_BLOCK)
        logits = (jnp.einsum('bhqd,bhkd->bhqk', qb, k) * scale
                  + Fb[..., :, None] - F[..., None, :])
        logits = jnp.where(kpos[None, :] <= qpos[:, None], logits, -jnp.inf)
        p = jax.nn.softmax(logits, axis=-1)
        return jnp.einsum('bhqk,bhkd->bhqd', p, v)

    out = lax.map(block, jnp.arange(nb))
    return jnp.moveaxis(out, 0, 2).reshape(B, H, S, dh)


def hybrid_mixer(h, w_in, m_conv_w, m_conv_b, m_i_bias, m_f_bias, m_out_norm_g,
                 f_f_bias, f_q_norm_g, f_k_norm_g, w_branch_m, w_branch_f, w_out):
    f32 = jnp.float32
    B, S, _ = h.shape
    z = (h @ w_in).astype(f32)
    split_idx = np.cumsum(IN_SIZES)[:-1].tolist()
    mq, mk, mv, mi, mf, mo, fq, fk, fv, ff, fo, ga, gb = jnp.split(z, split_idx, axis=-1)

    mqk = jax.nn.silu(causal_dwconv(jnp.concatenate([mq, mk], axis=-1),
                                    m_conv_w.astype(f32), m_conv_b.astype(f32)))
    mq, mk = mqk[..., :M_QK_W], mqk[..., M_QK_W:]
    i_pre = (mi + m_i_bias.astype(f32)).transpose(0, 2, 1)
    logf_m = jax.nn.log_sigmoid(mf + m_f_bias.astype(f32)).transpose(0, 2, 1)
    hm = mlstm_chunkwise(to_heads(mq, M_HEADS), to_heads(mk, M_HEADS),
                         to_heads(mv, M_HEADS), i_pre, logf_m)
    hm = rmsnorm(hm.transpose(0, 2, 1, 3), m_out_norm_g).reshape(B, S, M_V_W)
    hm = hm * jax.nn.sigmoid(mo)

    fq = rmsnorm(fq.reshape(B, S, F_HEADS, F_DH), f_q_norm_g).transpose(0, 2, 1, 3)
    fk = rmsnorm(fk.reshape(B, S, F_HEADS, F_DH), f_k_norm_g).transpose(0, 2, 1, 3)
    logf_f = jax.nn.log_sigmoid(ff + f_f_bias.astype(f32)).transpose(0, 2, 1)
    hf = forgetting_attention(fq, fk, to_heads(fv, F_HEADS), logf_f)
    hf = hf.transpose(0, 2, 1, 3).reshape(B, S, F_W) * jax.nn.sigmoid(fo)

    y = (jax.nn.sigmoid(ga) * (hm @ w_branch_m.astype(f32))
         + jax.nn.sigmoid(gb) * (hf @ w_branch_f.astype(f32)))
    return (y @ w_out.astype(f32)).astype(h.dtype)


def moe_ffn(h, w_router, b_router, w_gate_up, b_gate_up, w_down, b_down):
    B, S, D = h.shape
    t = h.reshape(B * S, D)
    logits = (t @ w_router + b_router).astype(jnp.float32)
    top_val, top_idx = lax.top_k(logits, TOP_K)
    top_w = jax.nn.softmax(top_val, axis=-1)
    dense_w = jnp.einsum('tk,tke->te', top_w,
                         jax.nn.one_hot(top_idx, N_EXPERTS, dtype=jnp.float32))

    def expert(acc, p):
        wgu, bgu, wd, bd, we = p
        gu = t @ wgu + bgu
        gate = jnp.minimum(gu[:, :D_FF], SWIGLU_LIMIT)
        up = jnp.clip(gu[:, D_FF:], -SWIGLU_LIMIT, SWIGLU_LIMIT)
        act = (up + 1.0) * gate * jax.nn.sigmoid(SWIGLU_ALPHA * gate)
        y = act @ wd + bd
        return acc + we[:, None] * y.astype(jnp.float32), None

    acc, _ = lax.scan(expert, jnp.zeros((B * S, D), jnp.float32),
                      (w_gate_up, b_gate_up, w_down, b_down, dense_w.T))
    return acc.astype(h.dtype).reshape(B, S, D)


def setup_inputs(seed: int = 0) -> dict:
    key = jax.random.key(seed)
    ks = jax.random.split(key, 25)
    D, L = D_MODEL, DEPTH

    def nrm(k, shape, s):
        return jax.random.normal(k, shape, jnp.float32) * s

    return {
        "x": nrm(ks[0], (BATCH, SEQ, D), 1.0),
        "c": nrm(ks[1], (BATCH, D), 1.0),
        "ada_w": nrm(ks[2], (L, D, 6 * D), 0.5 * D ** -0.5),
        "ada_b": nrm(ks[3], (L, 6 * D), 0.02),
        "norm1_g": 1.0 + nrm(ks[4], (L, D), 0.02),
        "w_in": nrm(ks[5], (L, D, IN_WIDTH), D ** -0.5),
        "m_conv_w": nrm(ks[6], (L, M_CONV, 2 * M_QK_W), M_CONV ** -0.5),
        "m_conv_b": nrm(ks[7], (L, 2 * M_QK_W), 0.02),
        "m_i_bias": nrm(ks[8], (L, M_HEADS), 0.1),
        "m_f_bias": 3.0 + nrm(ks[9], (L, M_HEADS), 0.5),
        "m_out_norm_g": 1.0 + nrm(ks[10], (L, M_HEADS, M_DV), 0.02),
        "f_f_bias": 3.0 + nrm(ks[11], (L, F_HEADS), 0.5),
        "f_q_norm_g": 1.0 + nrm(ks[12], (L, F_HEADS, F_DH), 0.02),
        "f_k_norm_g": 1.0 + nrm(ks[13], (L, F_HEADS, F_DH), 0.02),
        "w_branch_m": nrm(ks[14], (L, M_V_W, D), M_V_W ** -0.5),
        "w_branch_f": nrm(ks[15], (L, F_W, D), F_W ** -0.5),
        "w_out": nrm(ks[16], (L, D, D), D ** -0.5),
        "norm2_g": 1.0 + nrm(ks[17], (L, D), 0.02),
        "w_router": nrm(ks[18], (L, D, N_EXPERTS), D ** -0.5),
        "b_router": nrm(ks[19], (L, N_EXPERTS), 0.01),
        "w_gate_up": nrm(ks[20], (L, N_EXPERTS, D, 2 * D_FF), D ** -0.5),
        "b_gate_up": nrm(ks[21], (L, N_EXPERTS, 2 * D_FF), 0.02),
        "w_down": nrm(ks[22], (L, N_EXPERTS, D_FF, D), D_FF ** -0.5),
        "b_down": nrm(ks[23], (L, N_EXPERTS, D), 0.02),
        "final_norm_g": 1.0 + nrm(ks[24], (D,), 0.02),
    }


def reference(x, c, ada_w, ada_b, norm1_g, w_in, m_conv_w, m_conv_b, m_i_bias, m_f_bias,
              m_out_norm_g, f_f_bias, f_q_norm_g, f_k_norm_g, w_branch_m, w_branch_f, w_out,
              norm2_g, w_router, b_router, w_gate_up, b_gate_up, w_down, b_down, final_norm_g):
    sc = jax.nn.silu(c)
    for l in range(DEPTH):
        mod = (sc @ ada_w[l] + ada_b[l])[:, None, :]
        sh1, sc1, g1, sh2, sc2, g2 = jnp.split(mod, 6, axis=-1)
        h = rmsnorm(x, norm1_g[l]) * (1.0 + sc1) + sh1
        x = x + g1 * hybrid_mixer(h, w_in[l], m_conv_w[l], m_conv_b[l], m_i_bias[l], m_f_bias[l],
                                  m_out_norm_g[l], f_f_bias[l], f_q_norm_g[l], f_k_norm_g[l],
                                  w_branch_m[l], w_branch_f[l], w_out[l])
        h = rmsnorm(x, norm2_g[l]) * (1.0 + sc2) + sh2
        x = x + g2 * moe_ffn(h, w_router[l], b_router[l], w_gate_up[l], b_gate_up[l],
                             w_down[l], b_down[l])
    return rmsnorm(x, final_norm_g)
```

```cpp
#include <hip/hip_runtime.h>
#include <hip/hip_bf16.h>
#include <cstdio>
#include <cstdint>
#include <cmath>

#ifndef MK_N_LAUNCHES
#define MK_N_LAUNCHES 1
#endif
#ifndef MK_REP_PHASE
#define MK_REP_PHASE -1
#endif

namespace pg8 {
#define PG8_LAS __attribute__((address_space(3)))
typedef unsigned short bf16_t;
typedef short bf16x8 __attribute__((ext_vector_type(8)));
typedef float f32x4 __attribute__((ext_vector_type(4)));
typedef unsigned u32x4 __attribute__((ext_vector_type(4)));
constexpr int BM = 256, BK = 64, HALF = 128, HTB = HALF * BK * 2  , STAGE_BYTES = 8 * HTB, NXCD = 8, WGM = 8;

__host__ __device__ __forceinline__ int lds_byte(int r, int c) { const int st = (r >> 4) * 2 + (c >> 5), rr = r & 15, cc = c & 31, ob = rr * 64 + cc * 2; return st * 1024 + (ob ^ (((ob >> 9) & 1) << 5)); }
__host__ __device__ __forceinline__ void stage_rc(int b, int& R, int& C) { const int st = b / 1024, sb = b % 1024, swz = sb ^ (((sb >> 9) & 1) << 5); R = (st >> 1) * 16 + swz / 64; C = (st & 1) * 32 + (swz % 64) / 2; }
__host__ __device__ __forceinline__ int perm32(int rho) { const int n = rho >> 4, i = rho & 15; return 8 * (i >> 2) + 4 * n + (i & 3); }

struct Unit { int pm, pn, pa, half; };
struct Gemm { const bf16_t* A; const bf16_t* Bt; int M, N, K; };

struct StaticOrder {
    static constexpr bool ROW128 = false;
    int nM, nN, nwg, G, c;
    __host__ __device__ void init(int M, int N, int G_, int c_) { nM = M / BM; nN = N / BM; nwg = nM * nN; G = G_; c = c_; }
    __host__ __device__ bool next(int i, Unit& u) const {
        const long L = (long)i * G + c; if (L >= nwg) return false;
        int wgid = (int)L; { const int q = nwg / NXCD, r = nwg % NXCD, xcd = wgid % NXCD, off = wgid / NXCD; wgid = (xcd < r ? xcd * (q + 1) : r * (q + 1) + (xcd - r) * q) + off; }
        const int nig = WGM * nN, gid = wgid / nig, fm = gid * WGM, gsz = (nM - fm) < WGM ? (nM - fm) : WGM;
        u.pm = fm + ((wgid % nig) % gsz); u.pn = (wgid % nig) / gsz; u.pa = u.pm; u.half = 0; return true;
    }
    __device__ __forceinline__ void a_ready(const Unit&) const {}
    __device__ __forceinline__ void done(const Unit&) const {}
};

__device__ __forceinline__ unsigned cvt_pk_bf16(float lo, float hi) { unsigned r; asm volatile("v_cvt_pk_bf16_f32 %0, %1, %2" : "=v"(r) : "v"(lo), "v"(hi)); return r; }
typedef float f32x2 __attribute__((ext_vector_type(2)));
__device__ __forceinline__ f32x2 gelu_pk(f32x2 v) {
    const f32x2 av = __builtin_elementwise_abs(v), d = av * 0.2316418882f + 1.0f;
    f32x2 t; t.x = __builtin_amdgcn_rcpf(d.x); t.y = __builtin_amdgcn_rcpf(d.y);
    f32x2 q = t * 0.5307027145f + (-0.7265760135f); q = q * t + 0.7107068705f; q = q * t + (-0.142248368f); q = q * t + 0.127414796f; q = q * t;
    const f32x2 s = (v * v) * (-0.72134752044f);
    f32x2 e; e.x = __builtin_amdgcn_exp2f(s.x); e.y = __builtin_amdgcn_exp2f(s.y);
    const f32x2 m = v * (q * e), r = v - m;
    f32x2 o; o.x = v.x < 0.f ? m.x : r.x; o.y = v.y < 0.f ? m.y : r.y; return o;
}

template <int ACT  > struct EpiBf16 {
    static constexpr bool PERM = true, AFTER_DRAIN = false, HAS_MID = false; static_assert(ACT == 0 || ACT == 1, "EpiBf16: ACT is 0 (none) or 1 (gelu_pk)");
    bf16_t* O; int ldc; const float* bias; int split_cols; size_t split_stride; float scale0;
    __device__ __forceinline__ void operator()(const f32x4 (&acc)[2][2][4][2], const Unit& u, int wr, int wc, int fr, int fq) const {
        const int row0 = u.pm * BM + wr * 64 + fr; int colt = u.pn * BM; bf16_t* base = O;
        float sc = 1.f; if (split_cols) { const int t = colt / split_cols; base += (size_t)t * split_stride; colt -= t * split_cols; if (t == 0) sc = scale0; }
        const int col0 = colt + wc * 32 + 8 * fq, bcol0 = u.pn * BM + wc * 32 + 8 * fq;
        f32x4 bv[2][2];
#pragma unroll
        for (int bj = 0; bj < 2; ++bj)
#pragma unroll
            for (int n = 0; n < 2; ++n) bv[bj][n] = bias ? *(const f32x4*)(bias + bcol0 + bj * HALF + 4 * n) : (f32x4){0.f, 0.f, 0.f, 0.f};
#pragma unroll
        for (int ai = 0; ai < 2; ++ai)
#pragma unroll
            for (int m = 0; m < 4; ++m) { bf16_t* rowp = base + (size_t)(row0 + ai * HALF + m * 16) * ldc + col0;
#pragma unroll
                for (int bj = 0; bj < 2; ++bj) { f32x4 v0 = acc[ai][bj][m][0] + bv[bj][0], v1 = acc[ai][bj][m][1] + bv[bj][1];
                    if (ACT == 1) { f32x2 a = gelu_pk((f32x2){v0[0], v0[1]}), b = gelu_pk((f32x2){v0[2], v0[3]}), c = gelu_pk((f32x2){v1[0], v1[1]}), d = gelu_pk((f32x2){v1[2], v1[3]});
                        v0 = (f32x4){a.x, a.y, b.x, b.y}; v1 = (f32x4){c.x, c.y, d.x, d.y}; }
                    v0 = v0 * sc; v1 = v1 * sc; u32x4 w; w.x = cvt_pk_bf16(v0[0], v0[1]); w.y = cvt_pk_bf16(v0[2], v0[3]); w.z = cvt_pk_bf16(v1[0], v1[1]); w.w = cvt_pk_bf16(v1[2], v1[3]);
                    *(u32x4*)(rowp + bj * HALF) = w; } }
    }
};
__device__ __forceinline__ float bf2f(unsigned short h) { return __builtin_bit_cast(float, (unsigned)h << 16); }
__device__ __forceinline__ float sigmoidf_(float x) { return __builtin_amdgcn_rcpf(1.f + __builtin_amdgcn_exp2f(-1.4426950408889634f * x)); }
constexpr int ZLD = 11264;
__device__ __forceinline__ unsigned pack_fp8x4(float a, float b, float c, float d) { int w = __builtin_amdgcn_cvt_pk_fp8_f32(a, b, 0, false); w = __builtin_amdgcn_cvt_pk_fp8_f32(c, d, w, true); return (unsigned)w; }
struct EpiZ {
    static constexpr bool PERM = true, AFTER_DRAIN = false, HAS_MID = false;
    bf16_t* Z; float* G24; float sc;
    __device__ __forceinline__ void operator()(const f32x4 (&acc)[2][2][4][2], const Unit& u, int wr, int wc, int fr, int fq) const {
        const int row0 = u.pm * BM + wr * 64 + fr;
        if (u.pn < 44) {
            const int col0 = u.pn * BM + wc * 32 + 8 * fq;
#pragma unroll
            for (int ai = 0; ai < 2; ++ai)
#pragma unroll
                for (int m = 0; m < 4; ++m) { bf16_t* rowp = Z + (size_t)(row0 + ai * HALF + m * 16) * ZLD + col0;
#pragma unroll
                    for (int bj = 0; bj < 2; ++bj) { const f32x4 v0 = acc[ai][bj][m][0] * sc, v1 = acc[ai][bj][m][1] * sc;
                        u32x4 w; w.x = cvt_pk_bf16(v0[0], v0[1]); w.y = cvt_pk_bf16(v0[2], v0[3]); w.z = cvt_pk_bf16(v1[0], v1[1]); w.w = cvt_pk_bf16(v1[2], v1[3]);
                        *(u32x4*)(rowp + bj * HALF) = w; } }
        } else if (wc == 0 && fq < 3) {
#pragma unroll
            for (int ai = 0; ai < 2; ++ai)
#pragma unroll
                for (int m = 0; m < 4; ++m) { float* gp = G24 + (size_t)(row0 + ai * HALF + m * 16) * 24 + 8 * fq;
                    *(f32x4*)gp = acc[ai][0][m][0]; *(f32x4*)(gp + 4) = acc[ai][0][m][1]; }
        }
    }
};
struct EpiBranch {
    static constexpr bool PERM = true, AFTER_DRAIN = false, HAS_MID = true;
    bf16_t* Y; const bf16_t* Z; int zga, zgb;
    __device__ __forceinline__ void mid(f32x4 (&acc)[2][2][4][2], const Unit& u, int wr, int wc, int fr, int fq) const {
        asm volatile("" : "+v"(fr), "+v"(fq));
        const int row0 = u.pm * BM + wr * 64 + fr, col0 = u.pn * BM + wc * 32 + 8 * fq;
#pragma unroll
        for (int ai = 0; ai < 2; ++ai)
#pragma unroll
            for (int m = 0; m < 4; ++m) { const bf16_t* zr = Z + (size_t)(row0 + ai * HALF + m * 16) * ZLD + col0;
#pragma unroll
                for (int bj = 0; bj < 2; ++bj) { const u32x4 ga = *(const u32x4*)(zr + zga + bj * HALF), gb = *(const u32x4*)(zr + zgb + bj * HALF);
#pragma unroll
                    for (int n = 0; n < 2; ++n) { f32x4 r;
#pragma unroll
                        for (int i = 0; i < 4; ++i) { const unsigned wa = ga[2 * n + (i >> 1)], wb = gb[2 * n + (i >> 1)];
                            const float xa = (i & 1) ? __builtin_bit_cast(float, wa & 0xffff0000u) : __builtin_bit_cast(float, wa << 16), xb = (i & 1) ? __builtin_bit_cast(float, wb & 0xffff0000u) : __builtin_bit_cast(float, wb << 16);
                            r[i] = (1.f + __builtin_amdgcn_exp2f(-1.4426950408889634f * fmaxf(xb, -80.f))) * __builtin_amdgcn_rcpf(1.f + __builtin_amdgcn_exp2f(-1.4426950408889634f * fmaxf(xa, -80.f))); }
                        acc[ai][bj][m][n] *= r; } } }
    }
    __device__ __forceinline__ void operator()(const f32x4 (&acc)[2][2][4][2], const Unit& u, int wr, int wc, int fr, int fq) const {
        asm volatile("" : "+v"(fr), "+v"(fq));
        const int row0 = u.pm * BM + wr * 64 + fr, col0 = u.pn * BM + wc * 32 + 8 * fq;
#pragma unroll
        for (int ai = 0; ai < 2; ++ai)
#pragma unroll
            for (int m = 0; m < 4; ++m) { const size_t row = (size_t)(row0 + ai * HALF + m * 16);
#pragma unroll
                for (int bj = 0; bj < 2; ++bj) { const u32x4 gb = *(const u32x4*)(Z + row * ZLD + zgb + col0 + bj * HALF); float y[8];
#pragma unroll
                    for (int n = 0; n < 2; ++n)
#pragma unroll
                        for (int i = 0; i < 4; ++i) { const unsigned wb = gb[2 * n + (i >> 1)]; const float xb = (i & 1) ? __builtin_bit_cast(float, wb & 0xffff0000u) : __builtin_bit_cast(float, wb << 16);
                            y[4 * n + i] = acc[ai][bj][m][n][i] * sigmoidf_(fmaxf(xb, -80.f)); }
                    u32x4 w; w.x = cvt_pk_bf16(y[0], y[1]); w.y = cvt_pk_bf16(y[2], y[3]); w.z = cvt_pk_bf16(y[4], y[5]); w.w = cvt_pk_bf16(y[6], y[7]);
                    *(u32x4*)(Y + row * 2048 + col0 + bj * HALF) = w; } }
    }
};
struct EpiResF32 {
    static constexpr bool PERM = false, AFTER_DRAIN = false, HAS_MID = false;
    float* O; const float* X; const float* gate;
    __device__ __forceinline__ void operator()(const f32x4 (&acc)[2][2][4][2], const Unit& u, int wr, int wc, int fr, int fq) const {
        const int row0 = u.pm * BM + wr * 64 + fr, col0 = u.pn * BM + wc * 32 + 4 * fq;
        f32x4 gv[2][2];
#pragma unroll
        for (int bj = 0; bj < 2; ++bj)
#pragma unroll
            for (int n = 0; n < 2; ++n) gv[bj][n] = *(const f32x4*)(gate + col0 + bj * HALF + n * 16);
#pragma unroll
        for (int ai = 0; ai < 2; ++ai)
#pragma unroll
            for (int m = 0; m < 4; ++m) { const size_t row = (size_t)(row0 + ai * HALF + m * 16);
#pragma unroll
                for (int bj = 0; bj < 2; ++bj)
#pragma unroll
                    for (int n = 0; n < 2; ++n) { const int col = col0 + bj * HALF + n * 16;
                        const f32x4 xv = *(const f32x4*)(X + row * 2048 + col);
                        *(f32x4*)(O + row * 2048 + col) = xv + gv[bj][n] * acc[ai][bj][m][n]; } }
    }
};
struct EpiSwiglu {
    static constexpr bool PERM = true, AFTER_DRAIN = false, HAS_MID = false;
    unsigned char* ACT; const float* bgu;
    __device__ __forceinline__ void operator()(const f32x4 (&acc)[2][2][4][2], const Unit& u, int wr, int wc, int fr, int fq) const {
        asm volatile("" : "+v"(fr), "+v"(fq));
        const int e = u.pn >> 4, j = u.pn & 15, colL = 128 * j + wc * 32 + 8 * fq, row0 = u.pm * HALF + wr * 64 + fr;
        f32x4 bg[2], bu[2];
#pragma unroll
        for (int n = 0; n < 2; ++n) { bg[n] = *(const f32x4*)(bgu + (size_t)e * 4096 + colL + 4 * n); bu[n] = *(const f32x4*)(bgu + (size_t)e * 4096 + 2048 + colL + 4 * n); }
#pragma unroll
        for (int ai = 0; ai < 2; ++ai) if (!(ai == 1 && u.half))
#pragma unroll
            for (int m = 0; m < 4; ++m) { const size_t row = (size_t)(row0 + ai * HALF + m * 16);
                float a[8];
#pragma unroll
                for (int n = 0; n < 2; ++n)
#pragma unroll
                    for (int i = 0; i < 4; ++i) { float g = acc[ai][0][m][n][i] * 0.015625f + bg[n][i], up = acc[ai][1][m][n][i] * 0.015625f + bu[n][i];
                        g = fminf(g, 7.0f); up = fminf(fmaxf(up, -7.0f), 7.0f);
                        a[4 * n + i] = (up + 1.0f) * g * sigmoidf_(1.702f * g); }
                uint2 w; w.x = pack_fp8x4(a[0], a[1], a[2], a[3]); w.y = pack_fp8x4(a[4], a[5], a[6], a[7]);
                *(uint2*)(ACT + row * 2048 + colL) = w; }
    }
};
struct EpiDown {
    static constexpr bool PERM = true, AFTER_DRAIN = false, HAS_MID = false;
    unsigned char* YS; const float* bd; const float* SWE; const PG8_LAS int* eoff;
    __device__ __forceinline__ void operator()(const f32x4 (&acc)[2][2][4][2], const Unit& u, int wr, int wc, int fr, int fq) const {
        asm volatile("" : "+v"(fr), "+v"(fq));
        const int e = u.pn >> 3, j = u.pn & 7, col0 = 256 * j + wc * 32 + 8 * fq, row0 = u.pm * HALF + wr * 64 + fr; const int eoff0 = eoff[e];
        f32x4 bv[2][2];
#pragma unroll
        for (int bj = 0; bj < 2; ++bj)
#pragma unroll
            for (int n = 0; n < 2; ++n) bv[bj][n] = *(const f32x4*)(bd + (size_t)e * 2048 + col0 + bj * HALF + 4 * n);
#pragma unroll
        for (int ai = 0; ai < 2; ++ai) if (!(ai == 1 && u.half))
#pragma unroll
            for (int m = 0; m < 4; ++m) { const size_t row = (size_t)(row0 + ai * HALF + m * 16); const float sw = 32.f * SWE[(size_t)e * 8192 + (row - (size_t)eoff0)];
#pragma unroll
                for (int bj = 0; bj < 2; ++bj) { const f32x4 v0 = (acc[ai][bj][m][0] * 0.015625f + bv[bj][0]) * sw, v1 = (acc[ai][bj][m][1] * 0.015625f + bv[bj][1]) * sw;
                    uint2 w; w.x = pack_fp8x4(v0[0], v0[1], v0[2], v0[3]); w.y = pack_fp8x4(v1[0], v1[1], v1[2], v1[3]);
                    *(uint2*)(YS + row * 2048 + col0 + bj * HALF) = w; } }
    }
};
struct InOrderBf : StaticOrder { __device__ __forceinline__ bool next(int i, Unit& u) const { if (!StaticOrder::next(i, u)) return false; u.pn = u.pn < 8 ? u.pn : (u.pn < 20 ? u.pn + 4 : 44); return true; } };
struct InOrderF8 : StaticOrder { __device__ __forceinline__ bool next(int i, Unit& u) const { if (!StaticOrder::next(i, u)) return false; u.pn = u.pn < 4 ? 8 + u.pn : 20 + u.pn; return true; } };
struct MoeOrder {
    static constexpr bool ROW128 = true;
    const PG8_LAS int* tile_e; const PG8_LAS int* eoff; int ntiles, npn, G, c; bool a_in_region;
    __device__ __forceinline__ bool next(int i, Unit& u) const {
        int t, j;
        if (G == 256) {
            const int x = c & 7, w = c >> 3, bI = i * 8 + x; const int R = npn == 16 ? bI >> 1 : bI, jh = npn == 16 ? bI & 1 : 0;
            t = 4 * R + (w >> 3); j = 8 * jh + (w & 7); if (t >= ntiles) return false;
        } else { const long L = (long)i * G + c; if (L >= (long)ntiles * npn) return false; t = (int)(L / npn); j = (int)(L % npn); }
        const int te = __builtin_amdgcn_readfirstlane(tile_e[t]);
        const int e = te & 255, r128 = te >> 9; const int p0 = __builtin_amdgcn_readfirstlane(eoff[e]) >> 7;
        u.pm = p0 + r128; u.pn = e * npn + j; u.pa = a_in_region ? e * 66 + r128 : u.pm; u.half = (te >> 8) & 1; return true;
    }
    __device__ __forceinline__ void a_ready(const Unit&) const {}
    __device__ __forceinline__ void done(const Unit&) const {}
};
typedef int v4i_t __attribute__((ext_vector_type(4)));
typedef int v8i_t __attribute__((ext_vector_type(8)));
__device__ __forceinline__ v8i_t cat8(bf16x8 a, bf16x8 b) { const v4i_t x = __builtin_bit_cast(v4i_t, a), y = __builtin_bit_cast(v4i_t, b); return __builtin_shufflevector(x, y, 0, 1, 2, 3, 4, 5, 6, 7); }
template <class Epi, class Sched, bool ALIGN_EPI = false, bool SP2 = false, bool FP8 = false>
__device__ __forceinline__ void gemm_phase(PG8_LAS unsigned char* lds, const Gemm g, const Sched& S, const Epi& E) {
    const int tid = threadIdx.x, wid = __builtin_amdgcn_readfirstlane(tid >> 6), lane = tid & 63, wr = wid >> 2, wc = wid & 3, fr = lane & 15, fq = lane >> 4;
    const int K = g.K, PB = FP8 ? K : 2 * K  , nt = PB / (BK * 2);
    unsigned voffA[2], voffB[2];
#pragma unroll
    for (int i = 0; i < 2; ++i) { int R, C; stage_rc(tid * 16 + i * 8192, R, C); const int Rb = Epi::PERM ? ((R & ~31) + perm32(R & 31)) : R;
        voffA[i] = (unsigned)(R * PB + C * 2); voffB[i] = (unsigned)(Rb * PB + C * 2); }
    const size_t kstep = (size_t)(BK * 2);
    const size_t hstep = (size_t)HALF * PB;
    const size_t tstep = 2 * hstep;
    const unsigned ldsw = (unsigned)wid * 1024u;
    const int aoff = lds_byte(wr * 64 + fr, fq * 8), boff = lds_byte(wc * 32 + fr, fq * 8);
#define PG8_SA(b, h) (((b) * 2 + (h)) * HTB)
#define PG8_SB(b, h) ((4 + (b) * 2 + (h)) * HTB)
#define PG8_STAGE(bufoff, gbase, voff) do { _Pragma("unroll") for (int _i = 0; _i < 2; ++_i) \
        __builtin_amdgcn_global_load_lds((const unsigned*)((const char*)(gbase) + (voff)[_i]), (PG8_LAS unsigned*)(lds + (bufoff) + ldsw + _i * 8192), 16, 0, 0); } while (0)
#define PG8_LDA(dst, b, h) do { if constexpr (FP8) { _Pragma("unroll") for (int m = 0; m < 4; ++m) dst##8[m] = cat8(*(const PG8_LAS bf16x8*)(lds + PG8_SA(b, h) + aoff + m * 2048), *(const PG8_LAS bf16x8*)(lds + PG8_SA(b, h) + aoff + m * 2048 + 1024)); } \
        else { _Pragma("unroll") for (int m = 0; m < 4; ++m) _Pragma("unroll") for (int k = 0; k < 2; ++k) dst[m][k] = *(const PG8_LAS bf16x8*)(lds + PG8_SA(b, h) + aoff + m * 2048 + k * 1024); } } while (0)
#define PG8_LDB(dst, b, h) do { if constexpr (FP8) { _Pragma("unroll") for (int n = 0; n < 2; ++n) dst##8[n] = cat8(*(const PG8_LAS bf16x8*)(lds + PG8_SB(b, h) + boff + n * 2048), *(const PG8_LAS bf16x8*)(lds + PG8_SB(b, h) + boff + n * 2048 + 1024)); } \
        else { _Pragma("unroll") for (int n = 0; n < 2; ++n) _Pragma("unroll") for (int k = 0; k < 2; ++k) dst[n][k] = *(const PG8_LAS bf16x8*)(lds + PG8_SB(b, h) + boff + n * 2048 + k * 1024); } } while (0)
#define PG8_MMA(ai, bj, At, Bt) do { __builtin_amdgcn_s_setprio(1); if constexpr (FP8) { _Pragma("unroll") for (int m = 0; m < 4; ++m) _Pragma("unroll") for (int n = 0; n < 2; ++n) \
        asm volatile("v_mfma_f32_16x16x128_f8f6f4 %0, %1, %2, %0" : "+v"(acc[ai][bj][m][n]) : "v"(Bt##8[n]), "v"(At##8[m])); } \
        else { _Pragma("unroll") for (int m = 0; m < 4; ++m) _Pragma("unroll") for (int n = 0; n < 2; ++n) _Pragma("unroll") for (int k = 0; k < 2; ++k) \
        acc[ai][bj][m][n] = __builtin_amdgcn_mfma_f32_16x16x32_bf16(Bt[n][k], At[m][k], acc[ai][bj][m][n], 0, 0, 0); } __builtin_amdgcn_s_setprio(0); } while (0)
#define PG8_WAIT_V(n) asm volatile("s_waitcnt vmcnt(" #n ")" ::: "memory")
#define PG8_WAIT_L(n) asm volatile("s_waitcnt lgkmcnt(" #n ")" ::: "memory")
#define PG8_BAR __builtin_amdgcn_s_barrier()
#define PG8_SCHED __builtin_amdgcn_sched_barrier(0)
    Unit cur, nxt; int ui = 0;
    if (!S.next(0, cur)) return;
    f32x4 acc[2][2][4][2];
#pragma unroll
    for (int a = 0; a < 2; ++a)
#pragma unroll
        for (int b = 0; b < 2; ++b)
#pragma unroll
            for (int m = 0; m < 4; ++m)
#pragma unroll
                for (int n = 0; n < 2; ++n) acc[a][b][m][n] = (f32x4){0.f, 0.f, 0.f, 0.f};
    bf16x8 At[4][2], B0[2][2], B1[2][2]; v8i_t At8[4], B08[2], B18[2];
    const char* cA = (const char*)g.A + (size_t)cur.pa * (Sched::ROW128 ? hstep : tstep); const char* cB = (const char*)g.Bt + (size_t)cur.pn * tstep;
    S.a_ready(cur);
    if constexpr (SP2) {
        PG8_STAGE(PG8_SB(0, 0), cB, voffB); PG8_STAGE(PG8_SB(0, 1), cB + hstep, voffB); PG8_STAGE(PG8_SA(0, 0), cA, voffA); PG8_STAGE(PG8_SA(0, 1), cA + hstep, voffA);
        if (wr == 1) PG8_BAR;
        PG8_WAIT_V(2); PG8_BAR;
        PG8_STAGE(PG8_SB(1, 0), cB + kstep, voffB); PG8_STAGE(PG8_SA(1, 0), cA + kstep, voffA); PG8_STAGE(PG8_SB(1, 1), cB + hstep + kstep, voffB);
        PG8_WAIT_V(6); PG8_BAR;
    } else {
        PG8_STAGE(PG8_SB(0, 0), cB, voffB); PG8_STAGE(PG8_SA(0, 0), cA, voffA); PG8_STAGE(PG8_SB(0, 1), cB + hstep, voffB); PG8_STAGE(PG8_SA(0, 1), cA + hstep, voffA);
        if (wr == 1) PG8_BAR;
        PG8_WAIT_V(4); PG8_BAR;
        PG8_STAGE(PG8_SB(1, 0), cB + kstep, voffB); PG8_STAGE(PG8_SA(1, 0), cA + kstep, voffA); PG8_STAGE(PG8_SB(1, 1), cB + hstep + kstep, voffB);
        PG8_WAIT_V(6); PG8_BAR;
    }
    for (;;) {
        const bool has_next = S.next(ui + 1, nxt);
        const char* nA = has_next ? (const char*)g.A + (size_t)nxt.pa * (Sched::ROW128 ? hstep : tstep) : cA; const char* nB = has_next ? (const char*)g.Bt + (size_t)nxt.pn * tstep : cB;
        const bool hu = Sched::ROW128 && SP2 && cur.half != 0;
        for (int t = 0; t < nt; t += 2) {
            if constexpr (Epi::HAS_MID) { if (t == nt / 2) { E.mid(acc, cur, wr, wc, fr, fq); PG8_WAIT_V(0); } }
            const bool last = (t == nt - 2);
            const char* a1 = cA + (size_t)(t + 1) * kstep;
            const char* a2 = last ? nA : cA + (size_t)(t + 2) * kstep; const char* b2 = last ? nB : cB + (size_t)(t + 2) * kstep;
            const char* a3 = a2 + kstep; const char* b3 = b2 + kstep;
            if (last && has_next) S.a_ready(nxt);
            if constexpr (SP2) {
            PG8_LDB(B0, 0, 0); PG8_LDB(B1, 0, 1); PG8_SCHED; PG8_LDA(At, 0, 0); PG8_STAGE(PG8_SA(1, 1), a1 + hstep, voffA);
            PG8_WAIT_V(8); PG8_WAIT_L(0); PG8_BAR; PG8_MMA(0, 0, At, B0); PG8_MMA(0, 1, At, B1); PG8_BAR; PG8_SCHED;
            if (!hu) PG8_LDA(At, 0, 1); PG8_STAGE(PG8_SB(0, 0), b2, voffB); PG8_STAGE(PG8_SB(0, 1), b2 + hstep, voffB); PG8_STAGE(PG8_SA(0, 0), a2, voffA);
            PG8_WAIT_V(8); PG8_WAIT_L(0); PG8_BAR; if (!hu) { PG8_MMA(1, 0, At, B0); PG8_MMA(1, 1, At, B1); } PG8_BAR; PG8_SCHED;
            PG8_LDB(B0, 1, 0); PG8_LDB(B1, 1, 1); PG8_SCHED; PG8_LDA(At, 1, 0); PG8_STAGE(PG8_SA(0, 1), a2 + hstep, voffA);
            PG8_WAIT_V(8); PG8_WAIT_L(0); PG8_BAR; PG8_MMA(0, 0, At, B0); PG8_MMA(0, 1, At, B1); PG8_BAR; PG8_SCHED;
            if (!hu) PG8_LDA(At, 1, 1); PG8_STAGE(PG8_SB(1, 0), b3, voffB); PG8_STAGE(PG8_SB(1, 1), b3 + hstep, voffB); PG8_STAGE(PG8_SA(1, 0), a3, voffA);
            PG8_WAIT_V(8); PG8_WAIT_L(0); PG8_BAR; if (!hu) { PG8_MMA(1, 0, At, B0); PG8_MMA(1, 1, At, B1); } PG8_BAR; PG8_SCHED;
            } else {
            PG8_LDB(B0, 0, 0); PG8_SCHED; PG8_LDA(At, 0, 0); PG8_STAGE(PG8_SA(1, 1), a1 + hstep, voffA);
            PG8_WAIT_L(8); PG8_BAR; PG8_WAIT_L(0); PG8_MMA(0, 0, At, B0); PG8_BAR; PG8_SCHED;
            PG8_LDB(B1, 0, 1); PG8_STAGE(PG8_SB(0, 0), b2, voffB);
            PG8_BAR; PG8_WAIT_L(0); PG8_MMA(0, 1, At, B1); PG8_BAR;
            PG8_LDA(At, 0, 1); PG8_STAGE(PG8_SA(0, 0), a2, voffA);
            PG8_BAR; PG8_WAIT_L(0); PG8_MMA(1, 0, At, B0); PG8_BAR; PG8_SCHED;
            PG8_STAGE(PG8_SB(0, 1), b2 + hstep, voffB);
            PG8_WAIT_V(6); PG8_BAR; PG8_MMA(1, 1, At, B1); PG8_BAR;
            PG8_LDB(B0, 1, 0); PG8_SCHED; PG8_LDA(At, 1, 0); PG8_STAGE(PG8_SA(0, 1), a2 + hstep, voffA);
            PG8_WAIT_L(8); PG8_BAR; PG8_WAIT_L(0); PG8_MMA(0, 0, At, B0); PG8_BAR; PG8_SCHED;
            PG8_LDB(B1, 1, 1); PG8_STAGE(PG8_SB(1, 0), b3, voffB);
            PG8_BAR; PG8_WAIT_L(0); PG8_MMA(0, 1, At, B1); PG8_BAR;
            PG8_LDA(At, 1, 1); PG8_STAGE(PG8_SA(1, 0), a3, voffA);
            PG8_BAR; PG8_WAIT_L(0); PG8_MMA(1, 0, At, B0); PG8_BAR; PG8_SCHED;
            PG8_STAGE(PG8_SB(1, 1), b3 + hstep, voffB);
            PG8_WAIT_V(6); PG8_BAR; PG8_MMA(1, 1, At, B1); PG8_BAR;
            }
        }
        if constexpr (ALIGN_EPI) { if (wr == 0) PG8_BAR; }
        if constexpr (FP8) asm volatile("s_nop 15\n\ts_nop 15" ::: "memory");
        if constexpr (!Epi::AFTER_DRAIN) { E(acc, cur, wr, wc, fr, fq); S.done(cur); }
        if (!has_next) break;
#pragma unroll
        for (int a = 0; a < 2; ++a)
#pragma unroll
            for (int b = 0; b < 2; ++b)
#pragma unroll
                for (int m = 0; m < 4; ++m)
#pragma unroll
                    for (int n = 0; n < 2; ++n) acc[a][b][m][n] = (f32x4){0.f, 0.f, 0.f, 0.f};
        cur = nxt; cA = nA; cB = nB; ++ui;
        if constexpr (ALIGN_EPI) { if (wr == 1) PG8_BAR; }
    }
    PG8_WAIT_V(0);
    if constexpr (!ALIGN_EPI) { if (wr == 0) PG8_BAR; }
    PG8_BAR;
    if constexpr (Epi::AFTER_DRAIN) { E.fused(acc, cur, wr, wc, fr, fq, lds, wid, lane); S.done(cur); }
#undef PG8_SA
#undef PG8_SB
#undef PG8_STAGE
#undef PG8_LDA
#undef PG8_LDB
#undef PG8_MMA
#undef PG8_WAIT_V
#undef PG8_WAIT_L
#undef PG8_BAR
#undef PG8_SCHED
}
}

namespace fox {
constexpr int B = 1, H = 8, HKV = 8, SQ = 8192, SKV = 8192, D = 128, QOFF = 0, WINDOW = SKV;
constexpr float THR = 8.f;
constexpr bool WSKIP = false;
constexpr int ATT_QP = 1024, ATT_KP = 1024, ATT_VP = 11264, ATT_OP = 1024;
constexpr int ATT_BIAS_OFF = 69632;
constexpr float SCALE = 0.08838834764831845f;
constexpr int NW = 8, QBLK = 32, KVBLK = 64, QB = NW * QBLK;
constexpr int SHM_V = KVBLK * D * 2, SHM_K = KVBLK * D * 2;
constexpr int LDS_BYTES = 2 * SHM_V + 2 * SHM_K + NW * 64 * 4;
static_assert(D == 128 && SQ % QB == 0 && SKV % KVBLK == 0 && H % HKV == 0 && QOFF >= 0 && QOFF + SQ <= SKV && WINDOW >= 1, "geometry");

using bf16 = __hip_bfloat16;
typedef short bf16x8 __attribute__((ext_vector_type(8)));
typedef short s16x4 __attribute__((ext_vector_type(4)));
typedef float f32x16 __attribute__((ext_vector_type(16)));
typedef float f32x4 __attribute__((ext_vector_type(4)));
typedef unsigned u32x4 __attribute__((ext_vector_type(4)));
template <class A, class Bt> struct same_t { static constexpr bool v = false; };
template <class A> struct same_t<A, A> { static constexpr bool v = true; };

#define KSWZ(row, colB) ((row) * 256 + ((colB) ^ (((row) & 7) << 4)))
#define SBAR() __builtin_amdgcn_sched_barrier(0)
__device__ __forceinline__ int v_st(int k, int c) { const int kk = (k & ~0xC) | ((k & 4) << 1) | ((k & 8) >> 1); return ((kk >> 3) * 4 + (c >> 5)) * 512 + ((kk & 7) * 32 + (c & 31)) * 2; }
__device__ __forceinline__ int v_rd_base(int lane) { return ((lane & 3) << 3) | (((lane >> 2) & 3) << 6) | (((lane >> 4) & 1) << 5) | (((lane >> 5) & 1) << 8); }
constexpr int v_rd_off(int d0, int ks, int half) { return d0 * 512 + ks * 4096 + half * 2048; }
__device__ __forceinline__ int crow(int r, int hi) { return (r & 3) + 8 * (r >> 2) + 4 * hi; }
__device__ __forceinline__ unsigned cvtpk(float lo, float hi) {
    unsigned r; asm volatile("v_cvt_pk_bf16_f32 %0, %1, %2" : "=v"(r) : "v"(lo), "v"(hi)); return r;
}
__device__ __forceinline__ bf16x8 pack8(f32x4 a, f32x4 b) {
    u32x4 w = {cvtpk(a[0], a[1]), cvtpk(a[2], a[3]), cvtpk(b[0], b[1]), cvtpk(b[2], b[3])};
    return *reinterpret_cast<bf16x8*>(&w);
}
template <class T> __device__ __forceinline__ bf16x8 load8(const T* p) {
    if constexpr (same_t<T, float>::v) { return pack8(*(const f32x4*)p, *(const f32x4*)(p + 4)); }
    else { return *reinterpret_cast<const bf16x8*>(p); }
}
__device__ __forceinline__ void mask_tile(f32x16& p0, f32x16& p1, int dq, unsigned W) {
    const float NEG = -__builtin_inff();
#pragma unroll
    for (int r = 0; r < 16; ++r) {
        const int c = (r & 3) + 8 * (r >> 2);
        if ((unsigned)(dq - c) >= W) p0[r] = NEG;
        if ((unsigned)(dq - c - 32) >= W) p1[r] = NEG;
    }
}
__device__ __forceinline__ void partialSM(f32x16& p0, f32x16& p1, float& m_reg, float& mn, float& alpha) {
    float pmax = p0[0]; for (int r = 1; r < 16; ++r) pmax = fmaxf(pmax, p0[r]); for (int r = 0; r < 16; ++r) pmax = fmaxf(pmax, p1[r]);
    { auto rr = __builtin_amdgcn_permlane32_swap(__float_as_uint(pmax), __float_as_uint(pmax), false, false);
      pmax = fmaxf(__uint_as_float(rr[0]), __uint_as_float(rr[1])); }
    constexpr float C2 = 1.4426950408889634f * SCALE;
    if (__builtin_expect(__all((pmax - m_reg) * SCALE <= THR), 1)) { mn = m_reg; alpha = 1.f; }
    else { mn = fmaxf(m_reg, pmax); alpha = __builtin_amdgcn_exp2f((m_reg - mn) * C2); m_reg = mn; }
    const float mnL = -mn * C2;
    for (int r = 0; r < 16; ++r) p0[r] = fmaf(p0[r], C2, mnL); for (int r = 0; r < 16; ++r) p1[r] = fmaf(p1[r], C2, mnL);
    for (int r = 0; r < 16; ++r) p0[r] = __builtin_amdgcn_exp2f(p0[r]);
}
__device__ __forceinline__ void finishSM(f32x16& p0, f32x16& p1, float alpha, float& l_reg, bf16x8& pa0, bf16x8& pa1, bf16x8& pa2, bf16x8& pa3) {
    for (int r = 0; r < 16; ++r) p1[r] = __builtin_amdgcn_exp2f(p1[r]);
    float ps = 0; for (int r = 0; r < 16; ++r) ps += p0[r]; for (int r = 0; r < 16; ++r) ps += p1[r];
    { auto rr = __builtin_amdgcn_permlane32_swap(__float_as_uint(ps), __float_as_uint(ps), false, false);
      ps = __uint_as_float(rr[0]) + __uint_as_float(rr[1]); }
    l_reg = l_reg * alpha + ps;
#define PK4(P, B_, OUT) do { unsigned a0 = cvtpk(P[B_+0], P[B_+1]), a1 = cvtpk(P[B_+2], P[B_+3]);                          \
        unsigned b0 = cvtpk(P[B_+4], P[B_+5]), b1 = cvtpk(P[B_+6], P[B_+7]);                                             \
        auto r0 = __builtin_amdgcn_permlane32_swap(a0, b0, false, false); auto r1 = __builtin_amdgcn_permlane32_swap(a1, b1, false, false); \
        u32x4 w = {r0[0], r1[0], r0[1], r1[1]}; OUT = *reinterpret_cast<bf16x8*>(&w); } while (0)
    PK4(p0, 0, pa0); PK4(p0, 8, pa1); PK4(p1, 0, pa2); PK4(p1, 8, pa3);
#undef PK4
}
template <int KB, bool SK>
__device__ __forceinline__ void qkt(f32x16& p0, f32x16& p1, const char* K_lds, int r32, int hi, const bf16x8* qr, bool act, const float* bl) {
    if (SK && !act) { const float NEG = -__builtin_inff();
#pragma unroll
        for (int r = 0; r < 16; ++r) { p0[r] = NEG; p1[r] = NEG; } return; }
    {
        const f32x4 a0 = *(const f32x4*)(bl), a1 = *(const f32x4*)(bl + 8), a2 = *(const f32x4*)(bl + 16), a3 = *(const f32x4*)(bl + 24);
        const f32x4 c0 = *(const f32x4*)(bl + 32), c1 = *(const f32x4*)(bl + 40), c2 = *(const f32x4*)(bl + 48), c3 = *(const f32x4*)(bl + 56);
        p0 = (f32x16){a0[0], a0[1], a0[2], a0[3], a1[0], a1[1], a1[2], a1[3], a2[0], a2[1], a2[2], a2[3], a3[0], a3[1], a3[2], a3[3]};
        p1 = (f32x16){c0[0], c0[1], c0[2], c0[3], c1[0], c1[1], c1[2], c1[3], c2[0], c2[1], c2[2], c2[3], c3[0], c3[1], c3[2], c3[3]}; }
    const char* kb[4];
#pragma unroll
    for (int dd = 0; dd < 4; ++dd) kb[dd] = K_lds + KB * SHM_K + KSWZ(r32, (dd * 16 + hi * 8) * 2);
#pragma unroll
    for (int d0 = 0; d0 < 8; ++d0) { const char* a = kb[d0 & 3] + (d0 >> 2) * 128;
        bf16x8 b0 = *reinterpret_cast<const bf16x8*>(a);
        bf16x8 b1 = *reinterpret_cast<const bf16x8*>(a + 32 * 256);
        p0 = __builtin_amdgcn_mfma_f32_32x32x16_bf16(b0, qr[d0], p0, 0, 0, 0);
        p1 = __builtin_amdgcn_mfma_f32_32x32x16_bf16(b1, qr[d0], p1, 0, 0, 0); }
}
template <int VB, bool SK>
__device__ __forceinline__ void pv_tile(f32x16* o, int vb0, bf16x8 pa0, bf16x8 pa1, bf16x8 pa2, bf16x8 pa3, bool act) {
    if (SK && !act) return;
#define TRRD(dst, off) asm volatile("ds_read_b64_tr_b16 %0, %1 offset:%2" : "=&v"(dst) : "v"(vb0), "i"(off) : "memory")
#define PV_D0(d0) do { s16x4 l0, l1, l2, l3, h0, h1, h2, h3; constexpr int b_ = VB * SHM_V + v_rd_off(d0, 0, 0);     \
        TRRD(l0, b_); TRRD(h0, b_ + 2048); TRRD(l1, b_ + 4096); TRRD(h1, b_ + 6144); TRRD(l2, b_ + 8192); TRRD(h2, b_ + 10240); TRRD(l3, b_ + 12288); TRRD(h3, b_ + 14336); \
        asm volatile("s_waitcnt lgkmcnt(0)" ::: "memory"); SBAR();                 \
        o[d0] = __builtin_amdgcn_mfma_f32_32x32x16_bf16(pa0, (bf16x8){l0[0], l0[1], l0[2], l0[3], h0[0], h0[1], h0[2], h0[3]}, o[d0], 0, 0, 0);   \
        o[d0] = __builtin_amdgcn_mfma_f32_32x32x16_bf16(pa1, (bf16x8){l1[0], l1[1], l1[2], l1[3], h1[0], h1[1], h1[2], h1[3]}, o[d0], 0, 0, 0);   \
        o[d0] = __builtin_amdgcn_mfma_f32_32x32x16_bf16(pa2, (bf16x8){l2[0], l2[1], l2[2], l2[3], h2[0], h2[1], h2[2], h2[3]}, o[d0], 0, 0, 0);   \
        o[d0] = __builtin_amdgcn_mfma_f32_32x32x16_bf16(pa3, (bf16x8){l3[0], l3[1], l3[2], l3[3], h3[0], h3[1], h3[2], h3[3]}, o[d0], 0, 0, 0); } while (0)
    PV_D0(0); PV_D0(1); PV_D0(2); PV_D0(3);
#undef PV_D0
#undef TRRD
}

template <class TIn, class TOut> struct BlockRef { const TIn* Q; const TIn* K; const TIn* V; TOut* O; int P0; int jlo, jhi; bf16* PO; float* PML; };
template <class TIn> struct Seam {
    bf16x8 qr[8];
    bf16x8 st_v0, st_v1, st_k0, st_k1; f32x4 sf0, sf1, sf2, sf3;
    f32x4 tq[16];
};
__device__ __forceinline__ int swa_jlo(int P0, int W) { const int lowk = P0 - W + 1; return lowk > 0 ? lowk / KVBLK : 0; }
#define ROWK(p, k0, rr) ((p) + (size_t)((k0) + (rr)) * ATT_KP + sc)
#define ROWV(p, k0, rr) ((p) + (size_t)((k0) + (rr)) * ATT_VP + sc)
#define VMW() asm volatile("s_waitcnt vmcnt(0)" ::: "memory")
#define VMWN(n) asm volatile("s_waitcnt vmcnt(%0)" :: "i"(n) : "memory")
#define SLOAD_H(Kp, Vp, k0) do { S.st_v0 = load8<TIn>(ROWV(Vp, k0, sr)); S.st_v1 = load8<TIn>(ROWV(Vp, k0, 32 + sr));              \
                         S.st_k0 = load8<TIn>(ROWK(Kp, k0, sr)); S.st_k1 = load8<TIn>(ROWK(Kp, k0, 32 + sr)); } while (0)
#define SWRITE_HK(bf) do { *(bf16x8*)(K_lds + (bf) * SHM_K + kws) = S.st_k0; *(bf16x8*)(K_lds + (bf) * SHM_K + kws + 32 * 256) = S.st_k1; } while (0)
#define SWRITE_HV(bf) do { *(bf16x8*)(V_lds + (bf) * SHM_V + vst0) = S.st_v0; *(bf16x8*)(V_lds + (bf) * SHM_V + vst1) = S.st_v1; } while (0)
#define SWRITE_H(bf) do { SWRITE_HV(bf); SWRITE_HK(bf); } while (0)
#define SLOAD_F(p, k0) do { S.sf0 = *(const f32x4*)ROWK(p, k0, sr); S.sf1 = *(const f32x4*)(ROWK(p, k0, sr) + 4);                \
                            S.sf2 = *(const f32x4*)ROWK(p, k0, 32 + sr); S.sf3 = *(const f32x4*)(ROWK(p, k0, 32 + sr) + 4); } while (0)
#define SWRITE_KF(bf) do { *(bf16x8*)(K_lds + (bf) * SHM_K + kws) = pack8(S.sf0, S.sf1); *(bf16x8*)(K_lds + (bf) * SHM_K + kws + 32 * 256) = pack8(S.sf2, S.sf3); } while (0)
#define SWRITE_VF(bf) do { *(bf16x8*)(V_lds + (bf) * SHM_V + vst0) = pack8(S.sf0, S.sf1); *(bf16x8*)(V_lds + (bf) * SHM_V + vst1) = pack8(S.sf2, S.sf3); } while (0)
template <class TIn, class TOut>
__device__ __forceinline__ void causal_swa_prime(const BlockRef<TIn, TOut>& cur, int W, char* lds, Seam<TIn>& S) {
    constexpr bool F32 = same_t<TIn, float>::v;
    const int tid = threadIdx.x, wid = __builtin_amdgcn_readfirstlane(tid >> 6), lane = tid & 63, r32 = lane & 31, hi = lane >> 5;
    const int sr = tid >> 4, sc = (tid & 15) * 8, kws = KSWZ(sr, sc * 2); char* K_lds = lds + 2 * SHM_V;
    const int kb0 = cur.jlo * KVBLK;
    for (int d0 = 0; d0 < 8; ++d0) S.qr[d0] = load8<TIn>(cur.Q + (size_t)(wid * QBLK + r32) * ATT_QP + d0 * 16 + hi * 8);
    if constexpr (F32) { SLOAD_F((const float*)cur.K, kb0); VMW(); SWRITE_KF(0); SBAR(); SLOAD_F((const float*)cur.V, kb0); }
    else { SLOAD_H(cur.K, cur.V, kb0); VMW(); SWRITE_HK(0); }
    __syncthreads();
}
template <class TIn, class TOut>
__device__ __forceinline__ void causal_swa_block(const BlockRef<TIn, TOut>& cur, const BlockRef<TIn, TOut>& nxt, int skv, int W, char* lds, Seam<TIn>& S) {
    constexpr bool F32 = same_t<TIn, float>::v;
    const int tid = threadIdx.x, wid = __builtin_amdgcn_readfirstlane(tid >> 6), lane = tid & 63, r32 = lane & 31, hi = lane >> 5;
    const int j_lo = cur.jlo;
    const int j_hi = cur.jhi;
    const int NT = j_hi - j_lo;
    const int kbn = nxt.jlo * KVBLK;
    const int qlo = cur.P0 + wid * QBLK, qm = qlo + r32 - 4 * hi;
    char* V_lds = lds; char* K_lds = lds + 2 * SHM_V;
    float* ws = (float*)(lds + 2 * SHM_V + 2 * SHM_K) + wid * 64; float* li_l = ws, * al_l = ws + 32;
    const float* biasL = (const float*)(lds + ATT_BIAS_OFF);
    float m_reg = -1e30f, l_reg = 0; f32x16 o[4] = {};
    const int sr = tid >> 4, sc = (tid & 15) * 8, vst0 = v_st(sr, sc), vst1 = v_st(32 + sr, sc), kws = KSWZ(sr, sc * 2);
    const int vb0 = (int)(uintptr_t)V_lds + v_rd_base(lane);
    const TIn* Kh = cur.K; const TIn* Vh = cur.V;
#define RESC(a) do { if (__any((a) < 1.f)) { if (hi == 0) al_l[r32] = (a); asm volatile("s_waitcnt lgkmcnt(0)" ::: "memory");              \
                     for (int d_ = 0; d_ < 4; ++d_) for (int r = 0; r < 16; ++r) o[d_][r] *= al_l[crow(r, hi)]; } } while (0)
#define KBASE(t) ((j_lo + (t)) * KVBLK)
#define BIASP(t) (biasL + KBASE(t) + 4 * hi)
#define ACT(t) (KBASE(t) <= qlo + QBLK - 1 && KBASE(t) + KVBLK - 1 >= qlo - W + 1)
#define MASKT(P0_, P1_, t) do { const int kb_ = KBASE(t); if ((!SK || ACT(t)) && (kb_ + KVBLK - 1 > qlo || kb_ <= qlo + QBLK - 1 - W)) mask_tile(P0_, P1_, qm - kb_, (unsigned)W); } while (0)
    constexpr int NQL = F32 ? 16 : 8;
    constexpr bool SK = WSKIP && !F32;
#define SEAM_K0() do { VMWN(NQL); if constexpr (F32) { SWRITE_KF(0); SBAR(); SLOAD_F((const float*)nxt.V, kbn); } else { SWRITE_HK(0); } SBAR(); } while (0)
    f32x16 pA0, pA1, pB0, pB1; float mnA, mnB, alA, alB; bf16x8 pa0, pa1, pa2, pa3;
    if constexpr (F32) { VMW(); SWRITE_VF(0); SBAR(); } else { SWRITE_HV(0); SBAR(); }
    if (NT > 1) { if constexpr (F32) SLOAD_F((const float*)Kh, KBASE(1)); else SLOAD_H(Kh, Vh, KBASE(1)); }
    SBAR(); qkt<0, SK>(pA0, pA1, K_lds, r32, hi, S.qr, ACT(0), BIASP(0));
    if constexpr (F32) { if (NT > 1) { VMW(); SWRITE_KF(1); SBAR(); SLOAD_F((const float*)Vh, KBASE(1)); } }
    MASKT(pA0, pA1, 0); partialSM(pA0, pA1, m_reg, mnA, alA);
    if (NT > 1) { VMW(); if constexpr (F32) { SWRITE_VF(1); SBAR(); if (NT > 2) SLOAD_F((const float*)Kh, KBASE(2)); } else SWRITE_H(1); }
    __syncthreads();
#define HALF_STEP(PX0, PX1, mnX, alX, PY0, PY1, alY, t, KB, VB, SB) do {                                                      \
        SBAR(); qkt<KB, SK>(PX0, PX1, K_lds, r32, hi, S.qr, ACT(t), BIASP(t));                                             \
        finishSM(PY0, PY1, alY, l_reg, pa0, pa1, pa2, pa3); SBAR();                                                           \
        if ((t) + 1 < NT) { if constexpr (F32) { VMW(); SWRITE_KF(SB); SBAR(); SLOAD_F((const float*)Vh, KBASE((t) + 1)); }  \
                            else { SLOAD_H(Kh, Vh, KBASE((t) + 1)); } SBAR(); }                                               \
        pv_tile<VB, SK>(o, vb0, pa0, pa1, pa2, pa3, ACT((t) - 1)); MASKT(PX0, PX1, (t)); partialSM(PX0, PX1, m_reg, mnX, alX);                                        \
        __syncthreads();                                                                                                      \
        if ((t) + 1 < NT) { VMW(); if constexpr (F32) { SWRITE_VF(SB); SBAR(); if ((t) + 2 < NT) SLOAD_F((const float*)Kh, KBASE((t) + 2)); } \
                            else { SWRITE_H(SB); } }                                                                          \
        RESC(alX); __syncthreads(); } while (0)
    for (int t = 1; t + 1 < NT; t += 2) {
        HALF_STEP(pB0, pB1, mnB, alB, pA0, pA1, alA, t, 1, 0, 0);
        HALF_STEP(pA0, pA1, mnA, alA, pB0, pB1, alB, t + 1, 0, 1, 1);
    }
    const bool even = (NT & 1) == 0;
    if (even) { SBAR(); qkt<1, SK>(pB0, pB1, K_lds, r32, hi, S.qr, ACT(NT - 1), BIASP(NT - 1)); SBAR(); }
#define QROW(e) (nxt.Q + (size_t)(wid * QBLK + r32) * ATT_QP + ((e) >> 1) * 16 + hi * 8 + ((e) & 1) * 4)
    if constexpr (F32) { SLOAD_F((const float*)nxt.K, kbn); SBAR();
#pragma unroll
        for (int e = 0; e < 8; ++e) S.tq[e] = *(const f32x4*)QROW(e); }
    else { SLOAD_H(nxt.K, nxt.V, kbn); SBAR();
#pragma unroll
        for (int d0 = 0; d0 < 8; ++d0) S.qr[d0] = load8<TIn>(nxt.Q + (size_t)(wid * QBLK + r32) * ATT_QP + d0 * 16 + hi * 8); }
    SBAR();
    finishSM(pA0, pA1, alA, l_reg, pa0, pa1, pa2, pa3); SBAR();
    if constexpr (F32) {
#pragma unroll
        for (int e = 8; e < 16; ++e) S.tq[e] = *(const f32x4*)QROW(e); SBAR(); }
#undef QROW
    pv_tile<0, SK>(o, vb0, pa0, pa1, pa2, pa3, ACT(even ? NT - 2 : NT - 1));
    if (even) { MASKT(pB0, pB1, NT - 1); partialSM(pB0, pB1, m_reg, mnB, alB); __syncthreads(); RESC(alB);
        finishSM(pB0, pB1, alB, l_reg, pa0, pa1, pa2, pa3); SBAR(); pv_tile<1, SK>(o, vb0, pa0, pa1, pa2, pa3, ACT(NT - 1)); }
    SBAR(); SEAM_K0();
    {
        bf16* Pw = cur.PO + (size_t)(wid * QBLK) * 128;
#pragma unroll
        for (int r = 0; r < 16; ++r) { const int orow = crow(r, hi);
#pragma unroll
            for (int d0 = 0; d0 < 4; ++d0) { const float v = o[d0][r]; const float vn = __shfl_xor(v, 1);
                if ((r32 & 1) == 0) *(unsigned*)(Pw + (size_t)orow * 128 + d0 * 32 + r32) = cvtpk(v, vn); } }
        if (hi == 0) { cur.PML[wid * QBLK + r32] = m_reg; cur.PML[256 + wid * QBLK + r32] = l_reg; }
    }
    if constexpr (F32) {
#pragma unroll
        for (int d0 = 0; d0 < 8; ++d0) S.qr[d0] = pack8(S.tq[2 * d0], S.tq[2 * d0 + 1]); }
    __syncthreads();
#undef RESC
#undef KBASE
#undef BIASP
#undef ACT
#undef MASKT
#undef SEAM_K0
#undef HALF_STEP
}
#undef ROWK
#undef ROWV
#undef VMW
#undef VMWN
#undef SLOAD_H
#undef SWRITE_HK
#undef SWRITE_HV
#undef SWRITE_H
#undef SLOAD_F
#undef SWRITE_KF
#undef SWRITE_VF

}

constexpr int NWAVES = 8;
constexpr int S_ = 8192, DM = 2048, NEXP = 32, TOPK = 4, DFF = 2048;
constexpr int INW = 11288;
constexpr int NZT = 11520;
constexpr int NPH = 14;
constexpr int N_LAUNCHES = MK_N_LAUNCHES;
constexpr float EPS_ = 1e-6f;
constexpr int GW3 = 120;
constexpr int MPAD = 40960;

constexpr size_t MiB = 1u << 20;
constexpr size_t WS_CTL = 0, CTL_ZERO_BYTES = 1 * MiB;
constexpr size_t WS_MODP = 1 * MiB, WS_MOD = 4 * MiB, WS_WRT = 5 * MiB, WS_G24 = 6 * MiB, WS_EIDX = 7 * MiB, WS_ESLOT = 8 * MiB, WS_EW = 9 * MiB, WS_SW = 10 * MiB;
constexpr size_t WS_SC = 11 * MiB;
constexpr size_t WS_BL = 12 * MiB, WS_IPL = 13 * MiB, WS_FLOC = 14 * MiB, WS_UN = 15 * MiB, WS_NST = 16 * MiB;
constexpr size_t WS_WMT = 17 * MiB, WS_WFT = 21 * MiB, WS_WOUTT = 25 * MiB, WS_WINT = 33 * MiB;
constexpr size_t WS_XN = 78 * MiB, WS_QF = 110 * MiB, WS_KF = 126 * MiB, WS_OB = 142 * MiB, WS_HMF = 158 * MiB  , WS_QM = 190 * MiB, WS_KM = 206 * MiB;
constexpr size_t WS_U = 222 * MiB, WS_CST = 254 * MiB, WS_T1 = 286 * MiB, WS_Y = 350 * MiB, WS_Z = 382 * MiB, WS_XG = 558 * MiB, WS_ACT = 718 * MiB, WS_YS = 878 * MiB;
constexpr size_t WS_WGUT = 1038 * MiB, WS_WDT = 1550 * MiB;
constexpr size_t WS_PO = 1806 * MiB, WS_PML = 2318 * MiB, WS_NPART = 2326 * MiB;
constexpr size_t WS_XN8 = 558 * MiB  , WS_WINT8 = 286 * MiB  ;
constexpr size_t WS_XGE = 2327 * MiB, WS_SWE = 2860 * MiB, WS_END = 2861 * MiB;
static_assert(WS_WINT + (size_t)NZT * DM * 2 <= WS_XN && WS_Z + (size_t)S_ * 11264 * 2 <= WS_XG && WS_XG + (size_t)MPAD * DM * 2 <= WS_ACT, "ws map");
constexpr int CW_BAR = 4096;
constexpr int CW_CNT = 16384;
constexpr int CW_Q = 32768;

constexpr int RING_OFF = 0, RING_BYTES = 131072;
constexpr int LDSCTL_OFF = RING_BYTES, MISC_OFF = LDSCTL_OFF;
constexpr int TILE_E_OFF = LDSCTL_OFF + 256;
constexpr int EOFF_OFF = LDSCTL_OFF + 1024;
constexpr int LDS_BYTES = 147456;

#define GAS __attribute__((address_space(1)))
#define LAS __attribute__((address_space(3)))
typedef unsigned short bf16;
typedef unsigned v4u __attribute__((ext_vector_type(4)));
typedef unsigned v2u __attribute__((ext_vector_type(2)));
typedef float f32x4 __attribute__((ext_vector_type(4)));
typedef float f32x2_t __attribute__((ext_vector_type(2)));
typedef GAS unsigned gu32;
__device__ __forceinline__ unsigned f2bf(float f) { unsigned u = __builtin_bit_cast(unsigned, f); return (u + 0x7fffu + ((u >> 16) & 1u)) >> 16; }
typedef __bf16 bf16x2_hw __attribute__((ext_vector_type(2)));
__device__ __forceinline__ unsigned pk2(float lo, float hi) { const f32x2_t v = {lo, hi}; return __builtin_bit_cast(unsigned, __builtin_convertvector(v, bf16x2_hw)); }
__device__ __forceinline__ float bflo(unsigned w) { return __builtin_bit_cast(float, w << 16); }
__device__ __forceinline__ float bfhi(unsigned w) { return __builtin_bit_cast(float, w & 0xffff0000u); }
__device__ __forceinline__ float sigm(float x) { return __builtin_amdgcn_rcpf(1.f + __builtin_amdgcn_exp2f(-1.4426950408889634f * x)); }
__device__ __forceinline__ float logsig(float x) { const float e = __builtin_amdgcn_exp2f(-1.4426950408889634f * fabsf(x)); const float l = 0.6931471805599453f * __builtin_amdgcn_logf(1.f + e); return (x < 0.f ? x : 0.f) - l; }
__device__ __forceinline__ float wave_sum(float v) {
#pragma unroll
    for (int o = 1; o < 64; o <<= 1) v += __shfl_xor(v, o);
    return v;
}
__device__ __forceinline__ float wave_max(float v) {
#pragma unroll
    for (int o = 1; o < 64; o <<= 1) v = fmaxf(v, __shfl_xor(v, o));
    return v;
}
__device__ __forceinline__ float wave_scan_add(float v, int lane) {
#pragma unroll
    for (int o = 1; o < 64; o <<= 1) { const float t = __shfl_up(v, o); if (lane >= o) v += t; }
    return v;
}
__device__ __forceinline__ float wave_scan_max(float v, int lane) {
#pragma unroll
    for (int o = 1; o < 64; o <<= 1) { const float t = __shfl_up(v, o); if (lane >= o) v = fmaxf(v, t); }
    return v;
}

#define XB_TMO      128
#define XB_XCNT(j)  (256  + 64 * (j))
#define XB_XSUB(j)  (1280 + 64 * (j))
#define XB_XGEN(j)  (2304 + 64 * (j))
#define XB_TOP      3328
#define XB_TOPGEN   3392
#define XCD_BAR_WORDS 3456
#define XB_SPIN_CAP (1u << 18)

__device__ __forceinline__ unsigned xb_ld(unsigned* p)              { return __hip_atomic_load(p, __ATOMIC_RELAXED, __HIP_MEMORY_SCOPE_AGENT); }
__device__ __forceinline__ unsigned xb_add(unsigned* p, unsigned v) { return __hip_atomic_fetch_add(p, v, __ATOMIC_RELAXED, __HIP_MEMORY_SCOPE_AGENT); }
__device__ __forceinline__ unsigned xb_xcc_id() { return (unsigned)__builtin_amdgcn_s_getreg((3 << 11) | 20) & 0xFu; }
#define XB_SPIN(cond, bar) do { unsigned _sp = 0; while (cond) { __builtin_amdgcn_s_sleep(1); \
    if ((++_sp & 255u) == 0u) { if (xb_ld(&(bar)[XB_TMO])) break; if (_sp > XB_SPIN_CAP) { atomicAdd(&(bar)[XB_TMO], 1u); break; } } } } while (0)

struct XcdBarrier {
    unsigned* bar; unsigned x;
    volatile LAS unsigned* st;
};

__device__ __forceinline__ XcdBarrier xcd_barrier_post(unsigned* bar, volatile LAS unsigned* st) {
    XcdBarrier b; b.bar = bar; b.x = xb_xcc_id(); b.st = st;
    if (threadIdx.x == 0) (void)xb_add(&bar[XB_XCNT(b.x)], 1u);
    return b;
}
__device__ __forceinline__ void xcd_barrier_complete(unsigned* bar, unsigned x, unsigned& nloc, unsigned& nx) {
    const unsigned G = gridDim.x * gridDim.y * gridDim.z;
    unsigned sum, cnt, mine, sp = 0u;
    for (;;) {
        sum = 0u; cnt = 0u; mine = 0u;
#pragma unroll
        for (unsigned j = 0; j < 16; ++j) { const unsigned c = xb_ld(&bar[XB_XCNT(j)]); sum += c; cnt += (c > 0u) ? 1u : 0u; mine = (j == x) ? c : mine; }
        if (sum == G) break;
        __builtin_amdgcn_s_sleep(1);
        if ((++sp & 255u) == 0u) { if (xb_ld(&bar[XB_TMO])) break; if (sp > XB_SPIN_CAP) { atomicAdd(&bar[XB_TMO], 1u); break; } }
    }
    nloc = mine > 0u ? mine : 1u; nx = cnt > 0u ? cnt : 1u;
}

__device__ __forceinline__ void xcd_barrier(const XcdBarrier& b) {
    asm volatile("s_waitcnt vmcnt(0)" ::: "memory");
    __syncthreads();
    if (threadIdx.x == 0) {
        unsigned* bar = b.bar;
        __builtin_amdgcn_s_waitcnt(0);
        unsigned nloc = b.st[0], nx = b.st[1];
        if (nloc == 0u) { xcd_barrier_complete(bar, b.x, nloc, nx); b.st[0] = nloc; b.st[1] = nx; }
        const unsigned old = xb_add(&bar[XB_XSUB(b.x)], 1u);
        const unsigned gen = old / nloc;
        if (old + 1u == (gen + 1u) * nloc) {
            __builtin_amdgcn_fence(__ATOMIC_RELEASE, "agent");
            asm volatile("s_waitcnt vmcnt(0)" ::: "memory");
            const unsigned og = xb_add(&bar[XB_TOP], 1u);
            const unsigned tg = og / nx;
            if (og + 1u == (tg + 1u) * nx) xb_add(&bar[XB_TOPGEN], 1u);
            else XB_SPIN(xb_ld(&bar[XB_TOPGEN]) == tg, bar);
            __builtin_amdgcn_fence(__ATOMIC_ACQUIRE, "agent");
            xb_add(&bar[XB_XGEN(b.x)], 1u);
            asm volatile("s_waitcnt vmcnt(0)" ::: "memory");
        } else {
            XB_SPIN(xb_ld(&bar[XB_XGEN(b.x)]) == gen, bar);
            __builtin_amdgcn_fence(__ATOMIC_ACQUIRE, "agent");
            asm volatile("s_waitcnt vmcnt(0)" ::: "memory");
        }
    }
    __syncthreads();
}

struct Frame { LAS unsigned char* lds; int tid, lane, wave, vcu, G; };

struct Args { const float* in[25]; float* out; unsigned char* ws; int ph_lo, ph_hi; };
static_assert(sizeof(Args) == 25 * 8 + 8 + 8 + 8, "Args has no padding");

enum { I_X = 0, I_C, I_ADAW, I_ADAB, I_N1G, I_WIN, I_CONVW, I_CONVB, I_MIB, I_MFB, I_MONG, I_FFB, I_FQG, I_FKG, I_WBM, I_WBF, I_WOUT, I_N2G, I_WR, I_BR, I_WGU, I_BGU, I_WD, I_BD, I_FNG };

__device__ __forceinline__ void tr_item(const float* __restrict__ W, int N, int K, int k0, int src_n0, bf16* __restrict__ WT, int dst_row0, int lane, int dk = 0) {
    const int kq = lane >> 4, nq = lane & 15;
    const float* src = W + (size_t)(k0 + 16 * kq) * N + src_n0 + 4 * nq;
    f32x4 v[16];
#pragma unroll
    for (int j = 0; j < 16; ++j) v[j] = *(const f32x4*)(src + (size_t)j * N);
#pragma unroll
    for (int i = 0; i < 4; ++i) {
        v4u lo, hi;
        lo.x = pk2(v[0][i], v[1][i]); lo.y = pk2(v[2][i], v[3][i]); lo.z = pk2(v[4][i], v[5][i]); lo.w = pk2(v[6][i], v[7][i]);
        hi.x = pk2(v[8][i], v[9][i]); hi.y = pk2(v[10][i], v[11][i]); hi.z = pk2(v[12][i], v[13][i]); hi.w = pk2(v[14][i], v[15][i]);
        bf16* d = WT + (size_t)(dst_row0 + 4 * nq + i) * K + dk + k0 + 16 * kq;
        *(v4u*)d = lo; *(v4u*)(d + 8) = hi;
    }
}

__device__ __forceinline__ void tr_item8(const float* __restrict__ W, int N, int K, int k0, int src_n0, unsigned char* __restrict__ WT, int dst_row0, int lane) {
    const int kq = lane >> 4, nq = lane & 15;
    const float* src = W + (size_t)(k0 + 32 * kq) * N + src_n0 + 4 * nq;
    f32x4 v[32];
#pragma unroll
    for (int j = 0; j < 32; ++j) v[j] = __builtin_nontemporal_load((const f32x4*)(src + (size_t)j * N));
#pragma unroll
    for (int i = 0; i < 4; ++i) {
        v4u o0, o1;
        o0.x = pg8::pack_fp8x4(v[0][i] * 64.f, v[1][i] * 64.f, v[2][i] * 64.f, v[3][i] * 64.f); o0.y = pg8::pack_fp8x4(v[4][i] * 64.f, v[5][i] * 64.f, v[6][i] * 64.f, v[7][i] * 64.f);
        o0.z = pg8::pack_fp8x4(v[8][i] * 64.f, v[9][i] * 64.f, v[10][i] * 64.f, v[11][i] * 64.f); o0.w = pg8::pack_fp8x4(v[12][i] * 64.f, v[13][i] * 64.f, v[14][i] * 64.f, v[15][i] * 64.f);
        o1.x = pg8::pack_fp8x4(v[16][i] * 64.f, v[17][i] * 64.f, v[18][i] * 64.f, v[19][i] * 64.f); o1.y = pg8::pack_fp8x4(v[20][i] * 64.f, v[21][i] * 64.f, v[22][i] * 64.f, v[23][i] * 64.f);
        o1.z = pg8::pack_fp8x4(v[24][i] * 64.f, v[25][i] * 64.f, v[26][i] * 64.f, v[27][i] * 64.f); o1.w = pg8::pack_fp8x4(v[28][i] * 64.f, v[29][i] * 64.f, v[30][i] * 64.f, v[31][i] * 64.f);
        unsigned char* d = WT + (size_t)(dst_row0 + 4 * nq + i) * K + k0 + 32 * kq;
        __builtin_nontemporal_store(o0, (v4u*)d); __builtin_nontemporal_store(o1, (v4u*)(d + 16));
    }
}

__device__ __forceinline__ void ph0_prologue(const Frame& F, const Args& A) {
    unsigned char* ws = A.ws;
    const int gw = F.vcu * NWAVES + F.wave, NGW = F.G * NWAVES;
    {
        const float* c = A.in[I_C]; const float* aw = A.in[I_ADAW]; float* MODP = (float*)(ws + WS_MODP);
        for (int it = F.vcu; it < 64 * 6; it += F.G) {
            const int slab = it / 6, cb = it % 6, col = cb * 2048 + F.tid * 4;
            f32x4 acc = {0.f, 0.f, 0.f, 0.f};
#pragma unroll 8
            for (int k = slab * 32; k < slab * 32 + 32; ++k) { const float cv = c[k]; const float s = cv / (1.f + expf(-cv));
                const f32x4 w = *(const f32x4*)(aw + (size_t)k * 12288 + col); acc += w * s; }
            *(f32x4*)(MODP + (size_t)slab * 12288 + col) = acc;
        }
    }
    {
        const float* win = A.in[I_WIN]; bf16* WinT = (bf16*)(ws + WS_WINT); const float* wr = A.in[I_WR]; float* WRT = (float*)(ws + WS_WRT);
        const int gt = F.vcu * 512 + F.tid, NGT = F.G * 512;
        for (int idx = gt; idx < 24 * 2048; idx += NGT) { const int j = idx >> 11, k = idx & 2047; const int sc = j < 16 ? 2048 + j : 6160 + (j - 16);
            WinT[(size_t)(11264 + j) * 2048 + k] = (bf16)f2bf(win[(size_t)k * INW + sc]); }
        for (int idx = gt; idx < 32 * 2048; idx += NGT) { const int e = idx >> 11, k = idx & 2047; WRT[idx] = wr[(size_t)k * 32 + e]; }
    }
    {
        constexpr int I_IN = 32 * 80, I_IN8 = 16 * 96, I_M = 16 * 32, I_F = 16 * 32, I_O = 32 * 32;
        constexpr int NIT = I_IN + I_IN8 + I_M + I_F + I_O;
        for (int it = gw; it < NIT; it += NGW) {
            int r = it;
            if (r < I_IN) { const int kb = r / 80, nb = r % 80, dn = (nb < 32 ? nb : nb + 16) * 64; const int sn = dn < 2048 ? dn : dn + 16;
                tr_item(A.in[I_WIN], INW, 2048, kb * 64, sn, (bf16*)(ws + WS_WINT), dn, F.lane); continue; } r -= I_IN;
            if (r < I_IN8) { const int kb = r / 96, nb = r % 96, dn = (nb < 16 ? 32 + nb : 80 + nb) * 64; const int sn = dn < 6144 ? dn + 16 : dn + 24;
                tr_item8(A.in[I_WIN], INW, 2048, kb * 128, sn, (unsigned char*)(ws + WS_WINT8), dn, F.lane); continue; } r -= I_IN8;
            if (r < I_M) { const int kb = r / 32, nb = r % 32; tr_item(A.in[I_WBM], 2048, 2048, kb * 64, nb * 64, (bf16*)(ws + WS_WMT), nb * 64, F.lane, 0); continue; } r -= I_M;
            if (r < I_F) { const int kb = r / 32, nb = r % 32; tr_item(A.in[I_WBF], 2048, 2048, kb * 64, nb * 64, (bf16*)(ws + WS_WMT), nb * 64, F.lane, 1024); continue; } r -= I_F;
            { const int kb = r / 32, nb = r % 32; tr_item(A.in[I_WOUT], 2048, 2048, kb * 64, nb * 64, (bf16*)(ws + WS_WOUTT), nb * 64, F.lane); }
        }
    }
}

constexpr int MQ_GU = 32 * 1024, MQ_DN = 32 * 512, MQ_N = MQ_GU + MQ_DN, MQ_GRAB = 16;
__device__ __forceinline__ void mq_half_dma(const float* W, int N, int k0, int n0, LAS unsigned char* slice, int lane) {
    const float* src = W + (size_t)(k0 + (lane >> 4)) * N + n0 + 4 * (lane & 15);
#pragma unroll
    for (int j = 0; j < 16; ++j) __builtin_amdgcn_global_load_lds((const unsigned*)(src + (size_t)(4 * j) * N), (LAS unsigned*)(slice + j * 1024), 16, 0, 2);
}
__device__ __forceinline__ void mq_half_cvt(unsigned char* WT, int dst_row0, int k0, const LAS unsigned char* slice, int lane) {
    const int kq = lane >> 4, nq = lane & 15;
    f32x4 v[16];
#pragma unroll
    for (int i = 0; i < 16; ++i) v[i] = *(const LAS f32x4*)(slice + (16 * kq + i) * 256 + nq * 16);
#pragma unroll
    for (int i = 0; i < 4; ++i) { v4u o;
        o.x = pg8::pack_fp8x4(v[0][i] * 64.f, v[1][i] * 64.f, v[2][i] * 64.f, v[3][i] * 64.f); o.y = pg8::pack_fp8x4(v[4][i] * 64.f, v[5][i] * 64.f, v[6][i] * 64.f, v[7][i] * 64.f);
        o.z = pg8::pack_fp8x4(v[8][i] * 64.f, v[9][i] * 64.f, v[10][i] * 64.f, v[11][i] * 64.f); o.w = pg8::pack_fp8x4(v[12][i] * 64.f, v[13][i] * 64.f, v[14][i] * 64.f, v[15][i] * 64.f);
        __builtin_nontemporal_store(o, (v4u*)(WT + (size_t)(dst_row0 + 4 * nq + i) * 2048 + k0 + 16 * kq)); }
}
__device__ __forceinline__ void moe_convert_queue(const Frame& F, const Args& A) {
    unsigned char* ws = A.ws;
    unsigned* Q = (unsigned*)(ws + WS_CTL) + CW_Q;
    LAS int* qb = (LAS int*)(F.lds + LDSCTL_OFF + 1536);
    LAS unsigned char* slice = F.lds + RING_OFF + F.wave * 16384;
    for (;;) {
        __syncthreads();
        if (F.tid == 0) *qb = (int)__hip_atomic_fetch_add(Q, (unsigned)MQ_GRAB, __ATOMIC_RELAXED, __HIP_MEMORY_SCOPE_AGENT);
        __syncthreads();
        const int base = __builtin_amdgcn_readfirstlane(*qb);
        if (base >= MQ_N) break;
#pragma unroll 1
        for (int k = 0; k < 2 * (MQ_GRAB / NWAVES); ++k) { const int r = base + F.wave * (MQ_GRAB / NWAVES) + (k >> 1), kh = k & 1;
            const float* W; unsigned char* WT; int N, k0, n0, drow;
            if (r < MQ_GU) { const int e = r / 1024, rr = r % 1024, kb = rr / 64, nb = rr % 64; const int pn = nb >> 2, q = nb & 3;
                W = A.in[I_WGU] + (size_t)e * 2048 * 4096; N = 4096; k0 = kb * 128 + 64 * kh; n0 = (q >> 1) * 2048 + 128 * pn + (q & 1) * 64; WT = (unsigned char*)(ws + WS_WGUT) + (size_t)e * 4096 * 2048; drow = nb * 64; }
            else { const int r2 = r - MQ_GU, e = r2 / 512, rr = r2 % 512, kb = rr / 32, nb = rr % 32;
                W = A.in[I_WD] + (size_t)e * 2048 * 2048; N = 2048; k0 = kb * 128 + 64 * kh; n0 = nb * 64; WT = (unsigned char*)(ws + WS_WDT) + (size_t)e * 2048 * 2048; drow = nb * 64; }
            asm volatile("s_waitcnt lgkmcnt(0)" ::: "memory");
            mq_half_dma(W, N, k0, n0, slice, F.lane);
            asm volatile("s_waitcnt vmcnt(0)" ::: "memory");
            mq_half_cvt(WT, drow, k0, slice, F.lane);
        }
    }
}

__device__ __forceinline__ void ph1_modreduce(const Frame& F, const Args& A) {
    const float* MODP = (const float*)(A.ws + WS_MODP); float* MOD = (float*)(A.ws + WS_MOD); const float* ab = A.in[I_ADAB];
    for (int j = F.vcu * 512 + F.tid; j < 12288; j += F.G * 512) { float s = ab[j];
#pragma unroll 8
        for (int sl = 0; sl < 64; ++sl) s += MODP[(size_t)sl * 12288 + j];
        MOD[j] = s; }
}

__device__ __forceinline__ void ph2_norm1(const Frame& F, const Args& A) {
    const float* x = A.in[I_X]; const float* g1 = A.in[I_N1G]; const float* MOD = (const float*)(A.ws + WS_MOD); bf16* XN = (bf16*)(A.ws + WS_XN);
    const int gw = F.vcu * NWAVES + F.wave, NGW = F.G * NWAVES;
    for (int row = gw; row < S_; row += 2 * NGW) {
        const int rowb = row + NGW < S_ ? row + NGW : row;
        const f32x4* xa = (const f32x4*)(x + (size_t)row * DM) + F.lane; const f32x4* xb = (const f32x4*)(x + (size_t)rowb * DM) + F.lane;
        f32x4 va[8], vb[8]; float sa = 0.f, sb = 0.f;
#pragma unroll
        for (int j = 0; j < 8; ++j) { va[j] = xa[64 * j]; vb[j] = xb[64 * j]; }
#pragma unroll
        for (int j = 0; j < 8; ++j) { sa += (va[j].x * va[j].x + va[j].y * va[j].y) + (va[j].z * va[j].z + va[j].w * va[j].w); sb += (vb[j].x * vb[j].x + vb[j].y * vb[j].y) + (vb[j].z * vb[j].z + vb[j].w * vb[j].w); }
        const float ra = 1.f / sqrtf(wave_sum(sa) * (1.f / DM) + EPS_), rb = 1.f / sqrtf(wave_sum(sb) * (1.f / DM) + EPS_);
        unsigned long long* oa = (unsigned long long*)(XN + (size_t)row * DM) + F.lane; unsigned long long* ob = (unsigned long long*)(XN + (size_t)rowb * DM) + F.lane;
#pragma unroll
        for (int j = 0; j < 8; ++j) { const int col = 4 * F.lane + 256 * j;
            const f32x4 g = *(const f32x4*)(g1 + col), sh = *(const f32x4*)(MOD + col), sc = *(const f32x4*)(MOD + 2048 + col);
            const f32x4 ha = va[j] * ra * g * (sc + 1.f) + sh, hb = vb[j] * rb * g * (sc + 1.f) + sh;
            oa[64 * j] = (unsigned long long)pk2(ha.x, ha.y) | ((unsigned long long)pk2(ha.z, ha.w) << 32);
            ob[64 * j] = (unsigned long long)pk2(hb.x, hb.y) | ((unsigned long long)pk2(hb.z, hb.w) << 32);
            ((unsigned*)((unsigned char*)(A.ws + WS_XN8) + (size_t)row * DM) + F.lane)[64 * j] = pg8::pack_fp8x4(ha.x, ha.y, ha.z, ha.w);
            ((unsigned*)((unsigned char*)(A.ws + WS_XN8) + (size_t)rowb * DM) + F.lane)[64 * j] = pg8::pack_fp8x4(hb.x, hb.y, hb.z, hb.w); }
    }
}

#define TRRD_(dst, base, off) asm volatile("ds_read_b64_tr_b16 %0, %1 offset:%2" : "=&v"(dst) : "v"(base), "i"(off) : "memory")
#define TR8_(lo, hi) (fox::bf16x8){lo[0], lo[1], lo[2], lo[3], hi[0], hi[1], hi[2], hi[3]}
#define LDSW_() do { asm volatile("s_waitcnt lgkmcnt(0)" ::: "memory"); __builtin_amdgcn_sched_barrier(0); } while (0)
template <int DA, int DB> __device__ __forceinline__ void mm_tr_tr(fox::f32x16& acc, int ta, int tb) {
    fox::s16x4 a0, a1, a2, a3, a4, a5, a6, a7, b0, b1, b2, b3, b4, b5, b6, b7;
    TRRD_(a0, ta, DA * 512); TRRD_(a1, ta, DA * 512 + 2048); TRRD_(a2, ta, DA * 512 + 4096); TRRD_(a3, ta, DA * 512 + 6144);
    TRRD_(a4, ta, DA * 512 + 8192); TRRD_(a5, ta, DA * 512 + 10240); TRRD_(a6, ta, DA * 512 + 12288); TRRD_(a7, ta, DA * 512 + 14336);
    TRRD_(b0, tb, DB * 512); TRRD_(b1, tb, DB * 512 + 2048); TRRD_(b2, tb, DB * 512 + 4096); TRRD_(b3, tb, DB * 512 + 6144);
    TRRD_(b4, tb, DB * 512 + 8192); TRRD_(b5, tb, DB * 512 + 10240); TRRD_(b6, tb, DB * 512 + 12288); TRRD_(b7, tb, DB * 512 + 14336);
    LDSW_();
    acc = __builtin_amdgcn_mfma_f32_32x32x16_bf16(TR8_(a0, a1), TR8_(b0, b1), acc, 0, 0, 0);
    acc = __builtin_amdgcn_mfma_f32_32x32x16_bf16(TR8_(a2, a3), TR8_(b2, b3), acc, 0, 0, 0);
    acc = __builtin_amdgcn_mfma_f32_32x32x16_bf16(TR8_(a4, a5), TR8_(b4, b5), acc, 0, 0, 0);
    acc = __builtin_amdgcn_mfma_f32_32x32x16_bf16(TR8_(a6, a7), TR8_(b6, b7), acc, 0, 0, 0);
}
template <int DA> __device__ __forceinline__ void mm_tr_row(fox::f32x16& acc, int ta, const LAS bf16* brow) {
    fox::s16x4 a0, a1, a2, a3, a4, a5, a6, a7;
    TRRD_(a0, ta, DA * 512); TRRD_(a1, ta, DA * 512 + 2048); TRRD_(a2, ta, DA * 512 + 4096); TRRD_(a3, ta, DA * 512 + 6144);
    TRRD_(a4, ta, DA * 512 + 8192); TRRD_(a5, ta, DA * 512 + 10240); TRRD_(a6, ta, DA * 512 + 12288); TRRD_(a7, ta, DA * 512 + 14336);
    const fox::bf16x8 b0 = *(const LAS fox::bf16x8*)(brow), b1 = *(const LAS fox::bf16x8*)(brow + 16), b2 = *(const LAS fox::bf16x8*)(brow + 32), b3 = *(const LAS fox::bf16x8*)(brow + 48);
    LDSW_();
    acc = __builtin_amdgcn_mfma_f32_32x32x16_bf16(TR8_(a0, a1), b0, acc, 0, 0, 0);
    acc = __builtin_amdgcn_mfma_f32_32x32x16_bf16(TR8_(a2, a3), b1, acc, 0, 0, 0);
    acc = __builtin_amdgcn_mfma_f32_32x32x16_bf16(TR8_(a4, a5), b2, acc, 0, 0, 0);
    acc = __builtin_amdgcn_mfma_f32_32x32x16_bf16(TR8_(a6, a7), b3, acc, 0, 0, 0);
}
__device__ __forceinline__ void mm_row_row(fox::f32x16& acc, const LAS bf16* arow, const LAS bf16* brow) {
#pragma unroll
    for (int ks = 0; ks < 4; ++ks) acc = __builtin_amdgcn_mfma_f32_32x32x16_bf16(*(const LAS fox::bf16x8*)(arow + 16 * ks), *(const LAS fox::bf16x8*)(brow + 16 * ks), acc, 0, 0, 0);
}
constexpr int LP = 72;

__device__ __forceinline__ void ph4_unit(const Frame& F, const Args& A, int c, int h) {
    unsigned char* ws = A.ws;
    const bf16* Z = (const bf16*)(ws + WS_Z); const float* G24 = (const float*)(ws + WS_G24);
    LAS unsigned char* Vt = F.lds + RING_OFF;
    LAS unsigned char* Kw = Vt + 16384;
    LAS float* wkL = (LAS float*)(Kw + 16384);
    LAS float* uL = wkL + 64;
    const int t0 = c * 64, tid = F.tid, lane = F.lane;
    const int ch = tid & 127, tq = tid >> 7, isk = ch >> 6, d = ch & 63, zc = isk * 512 + h * 64 + d, tb = t0 + 16 * tq;
    float zin[19];
#pragma unroll
    for (int i = 0; i < 19; ++i) { const int tt = tb - 3 + i; zin[i] = tt >= 0 ? pg8::bf2f(Z[(size_t)tt * pg8::ZLD + zc]) : 0.f; }
    v4u vv[2];
#pragma unroll
    for (int i = 0; i < 2; ++i) { const int idx = tid + 512 * i, sx = idx >> 4, c8 = (idx & 15) * 8; vv[i] = *(const v4u*)(Z + (size_t)(t0 + sx) * pg8::ZLD + 1024 + h * 128 + c8); }
    unsigned qw[16];
#pragma unroll
    for (int i = 0; i < 16; ++i) { const int rv = F.wave * 16 + i, t = rv >> 1, isk2 = rv & 1, zc0 = 3072 + isk2 * 1024 + h * 128;
        qw[i] = *(const unsigned*)(Z + (size_t)(t0 + t) * pg8::ZLD + zc0 + 2 * lane); }
    const float* cw = A.in[I_CONVW]; const float w0 = cw[zc], w1 = cw[1024 + zc], w2 = cw[2048 + zc], w3 = cw[3072 + zc], bb = A.in[I_CONVB][zc];
    if (F.wave == 0) {
        const float* gr = G24 + (size_t)(t0 + lane) * 24;
        const float ip = gr[h] + A.in[I_MIB][h], lf = logsig(gr[8 + h] + A.in[I_MFB][h]), lff = logsig(gr[16 + h] + A.in[I_FFB][h]);
        const float b = wave_scan_add(lf, lane), fl = wave_scan_add(lff, lane), g = __shfl(b, 63);
        const float a = g - b + ip, amax = wave_max(a), wk = expf(a - amax);
        ((float*)(ws + WS_BL))[h * S_ + t0 + lane] = b; ((float*)(ws + WS_IPL))[h * S_ + t0 + lane] = ip; ((float*)(ws + WS_FLOC))[h * S_ + t0 + lane] = fl;
        wkL[lane] = wk; uL[lane] = 0.f;
        if (lane == 63) { float* SC = (float*)(ws + WS_SC); SC[h * 128 + c] = b; SC[1024 + h * 128 + c] = amax; SC[2048 + h * 128 + c] = fl; }
    }
#pragma unroll
    for (int i = 0; i < 2; ++i) { const int idx = tid + 512 * i, sx = idx >> 4, c8 = (idx & 15) * 8; *(LAS v4u*)(Vt + fox::v_st(sx, c8)) = vv[i]; }
    __syncthreads();
    {
        bf16* QMb = (bf16*)(ws + WS_QM); bf16* KMb = (bf16*)(ws + WS_KM);
        float usum = 0.f;
#pragma unroll
        for (int i = 0; i < 16; ++i) { const float y = bb + w0 * zin[i] + w1 * zin[i + 1] + w2 * zin[i + 2] + w3 * zin[i + 3];
            float sv = y * __builtin_amdgcn_rcpf(1.f + __builtin_amdgcn_exp2f(-1.4426950408889634f * y));
            if (isk) { sv *= 0.125f; const float kw = sv * wkL[16 * tq + i]; usum += kw;
                KMb[((size_t)h * S_ + tb + i) * 64 + d] = (bf16)f2bf(sv); *(LAS bf16*)(Kw + fox::v_st(16 * tq + i, d)) = (bf16)f2bf(kw); }
            else QMb[((size_t)h * S_ + tb + i) * 64 + d] = (bf16)f2bf(sv); }
        if (isk) __hip_atomic_fetch_add(uL + d, usum, __ATOMIC_RELAXED, __HIP_MEMORY_SCOPE_WORKGROUP);
    }
    __syncthreads();
    {
        const int eb = F.wave >> 1, db = F.wave & 1, r32 = lane & 31, hi = lane >> 5;
        const int ta = (int)(uintptr_t)Vt + fox::v_rd_base(lane), tbb = (int)(uintptr_t)Kw + fox::v_rd_base(lane);
        fox::f32x16 acc = {};
        if (eb == 0) { if (db == 0) mm_tr_tr<0, 0>(acc, ta, tbb); else mm_tr_tr<0, 1>(acc, ta, tbb); }
        else if (eb == 1) { if (db == 0) mm_tr_tr<1, 0>(acc, ta, tbb); else mm_tr_tr<1, 1>(acc, ta, tbb); }
        else if (eb == 2) { if (db == 0) mm_tr_tr<2, 0>(acc, ta, tbb); else mm_tr_tr<2, 1>(acc, ta, tbb); }
        else { if (db == 0) mm_tr_tr<3, 0>(acc, ta, tbb); else mm_tr_tr<3, 1>(acc, ta, tbb); }
        float* Up = (float*)(ws + WS_U) + ((size_t)h * 128 + c) * 8192 + 32 * db + r32;
#pragma unroll
        for (int i = 0; i < 16; ++i) Up[(size_t)(32 * eb + fox::crow(i, hi)) * 64] = acc[i];
        if (tid < 64) ((float*)(ws + WS_UN))[((size_t)h * 128 + c) * 64 + tid] = uL[tid];
    }
    {
        bf16* QF = (bf16*)(ws + WS_QF); bf16* KF = (bf16*)(ws + WS_KF);
        const float gq0 = A.in[I_FQG][h * 128 + 2 * lane], gq1 = A.in[I_FQG][h * 128 + 2 * lane + 1], gk0 = A.in[I_FKG][h * 128 + 2 * lane], gk1 = A.in[I_FKG][h * 128 + 2 * lane + 1];
        float rl;
        { float s0[16], s1[8], s2[4], s3[2];
          const bool b0 = lane & 1, b1 = lane & 2, b2 = lane & 4, b3 = lane & 8;
#pragma unroll
          for (int i = 0; i < 16; ++i) { const float x0 = bflo(qw[i]), x1 = bfhi(qw[i]); s0[i] = x0 * x0 + x1 * x1; }
#pragma unroll
          for (int k = 0; k < 8; ++k) s1[k] = (b0 ? s0[2 * k + 1] : s0[2 * k]) + __shfl_xor(b0 ? s0[2 * k] : s0[2 * k + 1], 1);
#pragma unroll
          for (int k = 0; k < 4; ++k) s2[k] = (b1 ? s1[2 * k + 1] : s1[2 * k]) + __shfl_xor(b1 ? s1[2 * k] : s1[2 * k + 1], 2);
#pragma unroll
          for (int k = 0; k < 2; ++k) s3[k] = (b2 ? s2[2 * k + 1] : s2[2 * k]) + __shfl_xor(b2 ? s2[2 * k] : s2[2 * k + 1], 4);
          float s4 = (b3 ? s3[1] : s3[0]) + __shfl_xor(b3 ? s3[0] : s3[1], 8);
          s4 += __shfl_xor(s4, 16); s4 += __shfl_xor(s4, 32);
          rl = __builtin_amdgcn_rsqf(s4 * (1.f / 128.f) + EPS_); }
#pragma unroll
        for (int i = 0; i < 16; ++i) { const int rv = F.wave * 16 + i, t = rv >> 1, isk2 = rv & 1; const float x0 = bflo(qw[i]), x1 = bfhi(qw[i]);
            const float r = __builtin_bit_cast(float, __builtin_amdgcn_readlane(__builtin_bit_cast(int, rl), i));
            *(unsigned*)((isk2 ? KF : QF) + (size_t)(t0 + t) * 1024 + h * 128 + 2 * lane) = pk2(x0 * r * (isk2 ? gk0 : gq0), x1 * r * (isk2 ? gk1 : gq1)); }
    }
    __syncthreads();
}

constexpr int T_INCL = 103424;
constexpr int T_COST = 107520;
constexpr int T_PREF = 108544;
constexpr int T_JLO  = 109600;
constexpr int T_TH   = 110624;
constexpr int T_DEC  = 111616;
constexpr int T_SCL  = 115712;
constexpr int T_OWN  = 119808;
constexpr int MAXP = 16;

__device__ __forceinline__ int fox_owner(int x, int total, int ge) { return (int)((((long)x + 1) * ge - 1) / total); }

__device__ __forceinline__ void ph5_tables(const Frame& F, const Args& A) {
    unsigned char* ws = A.ws; const float* SC = (const float*)(ws + WS_SC);
    LAS float* inclL = (LAS float*)(F.lds + T_INCL); LAS int* costL = (LAS int*)(F.lds + T_COST); LAS int* prefL = (LAS int*)(F.lds + T_PREF); LAS int* jloL = (LAS int*)(F.lds + T_JLO);
    LAS float* thL = (LAS float*)(F.lds + T_TH); LAS float* decL = (LAS float*)(F.lds + T_DEC); LAS float* sclL = (LAS float*)(F.lds + T_SCL);
    const int h = F.wave, l = F.lane;
    {
        const float v0 = SC[2048 + h * 128 + 2 * l], v1 = SC[2048 + h * 128 + 2 * l + 1]; const float sm = v0 + v1; const float incl = wave_scan_add(sm, l);
        inclL[h * 128 + 2 * l] = incl - v1; inclL[h * 128 + 2 * l + 1] = incl;
        const float* gq = A.in[I_FQG] + h * 128 + 2 * l; const float* gk = A.in[I_FKG] + h * 128 + 2 * l;
        const float gqm = wave_max(fmaxf(fabsf(gq[0]), fabsf(gq[1]))), gkm = wave_max(fmaxf(fabsf(gk[0]), fabsf(gk[1])));
        if (l == 0) thL[h] = 106.f + 2.f * 11.313708498984761f * gqm * gkm * 1.02f;
    }
    {
        const float g0 = SC[h * 128 + 2 * l], g1 = SC[h * 128 + 2 * l + 1], a0 = SC[1024 + h * 128 + 2 * l], a1 = SC[1024 + h * 128 + 2 * l + 1];
        const float gi1 = wave_scan_add(g0 + g1, l), gi0 = gi1 - g1, gx0 = gi0 - g0;
        const float val0 = a0 - gi0, val1 = a1 - gi1;
        const float pmi = wave_scan_max(fmaxf(val0, val1), l); float pme = __shfl_up(pmi, 1); if (l == 0) pme = -INFINITY;
        const float M0 = fmaxf(0.f, pme), M1 = fmaxf(M0, val0), M2 = fmaxf(M1, val1);
        const float m0 = M0 + gx0, m1 = M1 + gi0, m2 = M2 + gi1;
        decL[h * 128 + 2 * l] = expf(g0 + m0 - m1); sclL[h * 128 + 2 * l] = expf(a0 - m1);
        decL[h * 128 + 2 * l + 1] = expf(g1 + m1 - m2); sclL[h * 128 + 2 * l + 1] = expf(a1 - m2);
        if (F.vcu == 0) { float* MST = (float*)(ws + WS_SC) + 3072; MST[h * 128 + 2 * l] = m0; MST[h * 128 + 2 * l + 1] = m1; }
    }
    __syncthreads();
    int mycost = 0;
    if (F.tid < 256) { const int i = F.tid, hh = i >> 5, qb = i & 31; const float fref = qb ? inclL[hh * 128 + 4 * qb - 1] : 0.f, th = thL[hh];
        int lo = 0, hi2 = 4 * qb;
        while (lo < hi2) { const int mid = (lo + hi2) >> 1; if (fref - inclL[hh * 128 + mid] < -th) lo = mid + 1; else hi2 = mid; }
        jloL[i] = lo; mycost = 4 * (qb + 1) - lo; costL[i] = mycost; }
    {
        LAS int* wtot = prefL + 260;
        const int incl = (int)wave_scan_add((float)mycost, l);
        if (F.tid < 256 && l == 63) wtot[F.wave] = incl;
        __syncthreads();
        if (F.tid < 256) { int off = 0; for (int w = 0; w < F.wave; ++w) off += wtot[w]; prefL[F.tid] = off + incl - mycost; if (F.tid == 255) prefL[256] = off + incl; }
    }
    __syncthreads();
    {
        LAS int* ownL = (LAS int*)(F.lds + T_OWN);
        const int total = prefL[256]; int ge = total / 9; if (ge > F.G) ge = F.G; if (ge < 1) ge = 1;
        if (F.tid < 256) { const int i = F.tid; const int o0 = fox_owner(prefL[i], total, ge); ownL[i] = o0;
            if (F.vcu == 0) ((int*)(ws + WS_NPART))[i] = fox_owner(prefL[i] + mycost - 1, total, ge) - o0 + 1; }
        if (F.tid == 0) { ownL[256] = total; ownL[257] = ge; ownL[258] = (int)((long)total * F.vcu / ge); ownL[259] = (int)((long)total * (F.vcu + 1) / ge); }
    }
    __syncthreads();
}
__device__ __forceinline__ void ph5_m2(const Frame& F, const Args& A) {
    unsigned char* ws = A.ws;
    const LAS float* decL = (const LAS float*)(F.lds + T_DEC); const LAS float* sclL = (const LAS float*)(F.lds + T_SCL);
    LAS float* seg = (LAS float*)(F.lds + RING_OFF);
    const float* U = (const float*)(ws + WS_U); const float* UN = (const float*)(ws + WS_UN); bf16* CST = (bf16*)(ws + WS_CST); float* NST = (float*)(ws + WS_NST);
    const int g = F.wave, l = F.lane;
    constexpr int NT_C = 8 * 8192 / 128;
    for (int task0 = F.vcu; task0 < NT_C; task0 += 2 * F.G) {
        const bool hasB = task0 + F.G < NT_C;
        const int ttA = task0, ttB = hasB ? task0 + F.G : task0;
        const int hA = ttA >> 6, rA = (ttA * 128 + 2 * l) & 8191, jA = ttA & 63, hB = ttB >> 6, rB = (ttB * 128 + 2 * l) & 8191, jB = ttB & 63;
        const float* srcA = U + (size_t)hA * 128 * 8192 + rA; const float* srcB = U + (size_t)hB * 128 * 8192 + rB;
        const float* snA = UN + (size_t)hA * 128 * 64 + jA; const float* snB = UN + (size_t)hB * 128 * 64 + jB;
        f32x2_t uA[16], uB[16]; float nA[16], nB[16];
#pragma unroll
        for (int i = 0; i < 16; ++i) { uA[i] = *(const f32x2_t*)(srcA + (size_t)(16 * g + i) * 8192); uB[i] = *(const f32x2_t*)(srcB + (size_t)(16 * g + i) * 8192);
            nA[i] = snA[(16 * g + i) * 64]; nB[i] = snB[(16 * g + i) * 64]; }
        float ApA = 1.f, ApB = 1.f, BnA = 0.f, BnB = 0.f; f32x2_t BpA = {0.f, 0.f}, BpB = {0.f, 0.f};
#pragma unroll
        for (int i = 0; i < 16; ++i) { const float dA = decL[hA * 128 + 16 * g + i], sA = sclL[hA * 128 + 16 * g + i], dB = decL[hB * 128 + 16 * g + i], sB = sclL[hB * 128 + 16 * g + i];
            ApA *= dA; BpA = BpA * dA + uA[i] * sA; BnA = BnA * dA + nA[i] * sA; ApB *= dB; BpB = BpB * dB + uB[i] * sB; BnB = BnB * dB + nB[i] * sB; }
        seg[g * 128 + 2 * l] = ApA; seg[1024 + g * 128 + 2 * l] = BpA.x; seg[1024 + g * 128 + 2 * l + 1] = BpA.y; seg[2048 + g * 64 + l] = BnA;
        seg[3072 + g * 128 + 2 * l] = ApB; seg[3072 + 1024 + g * 128 + 2 * l] = BpB.x; seg[3072 + 1024 + g * 128 + 2 * l + 1] = BpB.y; seg[3072 + 2048 + g * 64 + l] = BnB;
        __syncthreads();
        f32x2_t stA = {0.f, 0.f}, stB = {0.f, 0.f}; float snsA = 0.f, snsB = 0.f;
        for (int q = 0; q < g; ++q) { const float a = seg[q * 128 + 2 * l], b = seg[3072 + q * 128 + 2 * l];
            stA.x = stA.x * a + seg[1024 + q * 128 + 2 * l]; stA.y = stA.y * a + seg[1024 + q * 128 + 2 * l + 1]; snsA = snsA * a + seg[2048 + q * 64 + l];
            stB.x = stB.x * b + seg[3072 + 1024 + q * 128 + 2 * l]; stB.y = stB.y * b + seg[3072 + 1024 + q * 128 + 2 * l + 1]; snsB = snsB * b + seg[3072 + 2048 + q * 64 + l]; }
        bf16* dA_ = CST + (size_t)hA * 128 * 8192 + rA; bf16* dB_ = CST + (size_t)hB * 128 * 8192 + rB;
        float* nsA = NST + (size_t)hA * 128 * 64 + jA; float* nsB = NST + (size_t)hB * 128 * 64 + jB;
#pragma unroll
        for (int i = 0; i < 16; ++i) { const float dA = decL[hA * 128 + 16 * g + i], sA = sclL[hA * 128 + 16 * g + i], dB = decL[hB * 128 + 16 * g + i], sB = sclL[hB * 128 + 16 * g + i];
            *(unsigned*)(dA_ + (size_t)(16 * g + i) * 8192) = pk2(stA.x, stA.y); if (l == 0) nsA[(16 * g + i) * 64] = snsA;
            stA = stA * dA + uA[i] * sA; snsA = snsA * dA + nA[i] * sA;
            if (hasB) { *(unsigned*)(dB_ + (size_t)(16 * g + i) * 8192) = pk2(stB.x, stB.y); if (l == 0) nsB[(16 * g + i) * 64] = snsB; }
            stB = stB * dB + uB[i] * sB; snsB = snsB * dB + nB[i] * sB; }
        __syncthreads();
    }
}

__device__ __forceinline__ void fox_fill_bias(const Frame& F, const Args& A, char* lds, int h, int klo, int khi) {
    int tid = threadIdx.x; asm volatile("" : "+v"(tid));
    const float* FLOC = (const float*)(A.ws + WS_FLOC);
    const float* inclL = (const float*)(lds + T_INCL); float* biasL = (float*)(lds + fox::ATT_BIAS_OFF);
    for (int s = klo + tid; s < khi; s += 512) { const int c = s >> 6; const float off = c ? inclL[h * 128 + c - 1] : 0.f;
        biasL[s] = -(off + FLOC[h * S_ + s]) * 11.313708498984761f; }
    __syncthreads();
}
__device__ __forceinline__ void ph5_attention(const Frame& F, const Args& A, char* lds) {
    using fbf = fox::bf16;
    unsigned char* ws = A.ws;
    const fbf* QF = (const fbf*)(ws + WS_QF); const fbf* KF = (const fbf*)(ws + WS_KF); const fbf* VZ = (const fbf*)(ws + WS_Z) + 5120;
    fbf* PO = (fbf*)(ws + WS_PO); float* PML = (float*)(ws + WS_PML);
    const int* costL = (const int*)(lds + T_COST); const int* prefL = (const int*)(lds + T_PREF); const int* jloL = (const int*)(lds + T_JLO);
    const int* ownL = (const int*)(lds + T_OWN);
    const int ge = __builtin_amdgcn_readfirstlane(ownL[257]);
    if (F.vcu >= ge) return;
    const int start = __builtin_amdgcn_readfirstlane(ownL[258]), end = __builtin_amdgcn_readfirstlane(ownL[259]);
    if (end <= start) return;
    int i = 0; { int lo = 0, hi = 255; while (lo < hi) { const int mid = (lo + hi + 1) >> 1; if (prefL[mid] <= start) lo = mid; else hi = mid - 1; } i = lo; }
#define FOX_RANGE(ii, ja_, jb_, h_, qb_, p_) do { h_ = (ii) >> 5; qb_ = (ii) & 31; const int ex_ = prefL[ii]; ja_ = jloL[ii] + (start > ex_ ? start - ex_ : 0); \
        jb_ = jloL[ii] + ((end - ex_ < costL[ii]) ? end - ex_ : costL[ii]); p_ = F.vcu - ownL[ii]; } while (0)
#define FOX_REF(hh, qb, ja_, jb_, pp) fox::BlockRef<fbf, fbf>{QF + (size_t)(qb) * 256 * 1024 + (hh) * 128, KF + (hh) * 128, VZ + (hh) * 128, (fbf*)nullptr, (qb) * 256, ja_, jb_, \
        PO + ((size_t)((hh) * 32 + (qb)) * MAXP + (pp)) * 32768, PML + ((size_t)((hh) * 32 + (qb)) * MAXP + (pp)) * 512}
    int h, qb, ja, jb, p; FOX_RANGE(i, ja, jb, h, qb, p);
    fox::BlockRef<fbf, fbf> cur = FOX_REF(h, qb, ja, jb, p);
    fox::Seam<fbf> S;
    int cur_h = -1;
#pragma unroll 1
    for (;;) {
        if (h != cur_h) {
            int tlo = ja, thi = jb;
            for (int ii = i + 1; ii < 256 && (ii >> 5) == h && prefL[ii] < end; ++ii) { const int a2 = jloL[ii], b2 = jloL[ii] + ((end - prefL[ii] < costL[ii]) ? end - prefL[ii] : costL[ii]); tlo = a2 < tlo ? a2 : tlo; thi = b2 > thi ? b2 : thi; }
            fox_fill_bias(F, A, lds, h, tlo * 64, thi * 64); fox::causal_swa_prime<fbf, fbf>(cur, fox::SKV, lds, S); cur_h = h; }
        const bool more = (i + 1 < 256) && (prefL[i + 1] < end);
        int hn = h, qbn = qb, jan = ja, jbn = jb, pn = p;
        if (more) FOX_RANGE(i + 1, jan, jbn, hn, qbn, pn);
        const bool chain = more && hn == h;
        const fox::BlockRef<fbf, fbf> nxt = chain ? FOX_REF(hn, qbn, jan, jbn, pn) : cur;
        fox::causal_swa_block<fbf, fbf>(cur, nxt, fox::SKV, fox::SKV, lds, S);
        if (!more) break;
        ++i; h = hn; qb = qbn; ja = jan; jb = jbn; p = pn; cur = chain ? nxt : FOX_REF(h, qb, ja, jb, p);
    }
#undef FOX_REF
#undef FOX_RANGE
}

__device__ __forceinline__ void ph6_unit(const Frame& F, const Args& A, int c, int h) {
    unsigned char* ws = A.ws;
    const bf16* Z = (const bf16*)(ws + WS_Z);
    LAS unsigned char* Vt = F.lds + RING_OFF;
    LAS bf16* Qb = (LAS bf16*)(Vt + 16384);
    LAS bf16* Kb = Qb + 64 * LP;
    LAS bf16* Sb = Kb + 64 * LP;
    LAS bf16* Cb = Sb + 64 * LP;
    LAS float* fl = (LAS float*)(Cb + 128 * LP);
    LAS float* btm = fl, *ibs = fl + 64, *mtL = fl + 128, *wiL = fl + 192, *nL = fl + 256, *qnL = fl + 320, *denS = fl + 384  , *ssq = fl + 512  ;
    const int t0 = c * 64, tid = F.tid, lane = F.lane, r32 = lane & 31, hi = lane >> 5;
    {
        const v4u* Qg = (const v4u*)((const bf16*)(ws + WS_QM) + ((size_t)h * S_ + t0) * 64); const v4u* Kg = (const v4u*)((const bf16*)(ws + WS_KM) + ((size_t)h * S_ + t0) * 64);
        const v4u* Cg = (const v4u*)((const bf16*)(ws + WS_CST) + ((size_t)h * 128 + c) * 8192);
        const v4u q4 = Qg[tid], k4 = Kg[tid], c40 = Cg[tid], c41 = Cg[tid + 512];
        v4u vv[2];
#pragma unroll
        for (int i = 0; i < 2; ++i) { const int idx = tid + 512 * i, sx = idx >> 4, c8 = (idx & 15) * 8; vv[i] = *(const v4u*)(Z + (size_t)(t0 + sx) * pg8::ZLD + 1024 + h * 128 + c8); }
        const float mprev = ((const float*)(ws + WS_SC))[3072 + h * 128 + c];
        if (F.wave == 0) { const float b = ((const float*)(ws + WS_BL))[h * S_ + t0 + lane], ip = ((const float*)(ws + WS_IPL))[h * S_ + t0 + lane];
            const float pm = wave_scan_max(ip - b, lane); const float mt = b + fmaxf(mprev, pm);
            mtL[lane] = mt; wiL[lane] = expf(b + mprev - mt); btm[lane] = b - mt; ibs[lane] = ip - b;
            nL[lane] = ((const float*)(ws + WS_NST))[((size_t)h * 128 + c) * 64 + lane]; }
        *(LAS v4u*)(Qb + (tid >> 3) * LP + (tid & 7) * 8) = q4; *(LAS v4u*)(Kb + (tid >> 3) * LP + (tid & 7) * 8) = k4;
        *(LAS v4u*)(Cb + (tid >> 3) * LP + (tid & 7) * 8) = c40; *(LAS v4u*)(Cb + (64 + (tid >> 3)) * LP + (tid & 7) * 8) = c41;
#pragma unroll
        for (int i = 0; i < 2; ++i) { const int idx = tid + 512 * i, sx = idx >> 4, c8 = (idx & 15) * 8; *(LAS v4u*)(Vt + fox::v_st(sx, c8)) = vv[i]; }
    }
    __syncthreads();
    if (F.wave < 4) {
        const int sb = F.wave >> 1, tb = F.wave & 1;
        fox::f32x16 acc = {};
        mm_row_row(acc, Kb + (32 * sb + r32) * LP + 8 * hi, Qb + (32 * tb + r32) * LP + 8 * hi);
        const int t = 32 * tb + r32; const float bt = btm[t]; float ps = 0.f;
#pragma unroll
        for (int g = 0; g < 4; ++g) { const int sg = 32 * sb + 8 * g + 4 * hi; const f32x4 ib = *(const LAS f32x4*)(ibs + sg);
            float w[4];
#pragma unroll
            for (int q = 0; q < 4; ++q) { const float v = (sg + q <= t) ? acc[4 * g + q] * __builtin_amdgcn_exp2f(1.4426950408889634f * (bt + ib[q])) : 0.f; w[q] = v; ps += v; }
            v2u pk; pk.x = pk2(w[0], w[1]); pk.y = pk2(w[2], w[3]); *(LAS v2u*)(Sb + t * LP + sg) = pk; }
        ps += __shfl_xor(ps, 32);
        if (hi == 0) denS[sb * 64 + t] = ps;
    } else {
        const int j = tid - 256, t = j >> 2, dq = (j & 3) * 16; float qn = 0.f;
#pragma unroll
        for (int i = 0; i < 16; ++i) qn += pg8::bf2f(Qb[t * LP + dq + i]) * nL[dq + i];
        qn += __shfl_xor(qn, 1); qn += __shfl_xor(qn, 2);
        if ((j & 3) == 0) qnL[t] = qn;
    }
    __syncthreads();
    const int eb = F.wave >> 1, tb = F.wave & 1, t = 32 * tb + r32;
    fox::f32x16 accS = {}, accC = {};
    {
        const int ta = (int)(uintptr_t)Vt + fox::v_rd_base(lane);
        const LAS bf16* srow = Sb + t * LP + 8 * hi;
        if (eb == 0) mm_tr_row<0>(accS, ta, srow); else if (eb == 1) mm_tr_row<1>(accS, ta, srow); else if (eb == 2) mm_tr_row<2>(accS, ta, srow); else mm_tr_row<3>(accS, ta, srow);
        mm_row_row(accC, Cb + (32 * eb + r32) * LP + 8 * hi, Qb + t * LP + 8 * hi);
    }
    const float mt = mtL[t], wi = wiL[t];
    const float den = denS[t] + denS[64 + t] + wi * qnL[t];
    const float inv = __builtin_amdgcn_rcpf(fmaxf(fabsf(den), expf(-mt)));
    float o[16]; float ss = 0.f;
#pragma unroll
    for (int i = 0; i < 16; ++i) { o[i] = (accS[i] + wi * accC[i]) * inv; ss += o[i] * o[i]; }
    ss += __shfl_xor(ss, 32);
    if (hi == 0) ssq[eb * 64 + t] = ss;
    __syncthreads();
    const float r = 1.f / sqrtf((ssq[t] + ssq[64 + t] + ssq[128 + t] + ssq[192 + t]) * (1.f / 128.f) + EPS_);
    const float* mg = A.in[I_MONG] + h * 128 + 32 * eb + 4 * hi;
    const bf16* og = Z + (size_t)(t0 + t) * pg8::ZLD + 2048 + h * 128 + 32 * eb + 4 * hi;
    bf16* hm = (bf16*)(ws + WS_HMF) + (size_t)(t0 + t) * 2048 + h * 128 + 32 * eb + 4 * hi;
#pragma unroll
    for (int g = 0; g < 4; ++g) { const uint2 ow = *(const uint2*)(og + 8 * g); const f32x4 gm = *(const f32x4*)(mg + 8 * g);
        uint2 pw; pw.x = pk2(o[4 * g] * r * gm.x * sigm(bflo(ow.x)), o[4 * g + 1] * r * gm.y * sigm(bfhi(ow.x)));
        pw.y = pk2(o[4 * g + 2] * r * gm.z * sigm(bflo(ow.y)), o[4 * g + 3] * r * gm.w * sigm(bfhi(ow.y)));
        *(uint2*)(hm + 8 * g) = pw; }
    __syncthreads();
}
__device__ __forceinline__ float rdl(float v, int l) { return __builtin_bit_cast(float, __builtin_amdgcn_readlane(__builtin_bit_cast(int, v), l)); }
__device__ __forceinline__ void ph6_hf(const Frame& F, const Args& A) {
    const bf16* PO = (const bf16*)(A.ws + WS_PO); const float* PML = (const float*)(A.ws + WS_PML); const int* NPART = (const int*)(A.ws + WS_NPART);
    const bf16* Z = (const bf16*)(A.ws + WS_Z); bf16* HF = (bf16*)(A.ws + WS_HMF) + 1024;
    constexpr float C2 = 1.4426950408889634f * 0.08838834764831845f;
    const int gw = F.vcu * NWAVES + F.wave, NGW = F.G * NWAVES, lane = F.lane;
    const int mlo = (lane & 7) + ((lane & 8) ? 256 : 0);
#pragma unroll 1
    for (int g = gw; g < S_; g += NGW) {
        const int h = g & 7, row0 = (g >> 3) * 8, blk = h * 32 + (row0 >> 8), rr0 = row0 & 255;
        const int np = __builtin_amdgcn_readfirstlane(NPART[blk]);
        const float* pm = PML + (size_t)blk * MAXP * 512 + rr0 + mlo; const bf16* po = PO + (size_t)blk * MAXP * 32768 + (size_t)rr0 * 128 + 2 * lane;
        unsigned gz[8], ov[8]; float M[8], L[8]; f32x2_t a[8];
        { const float ml = pm[0];
#pragma unroll
          for (int q = 0; q < 8; ++q) { ov[q] = *(const unsigned*)(po + q * 128); gz[q] = *(const unsigned*)(Z + (size_t)(row0 + q) * pg8::ZLD + 6144 + h * 128 + 2 * lane); }
#pragma unroll
          for (int q = 0; q < 8; ++q) { M[q] = rdl(ml, q); L[q] = rdl(ml, 8 + q); a[q].x = bflo(ov[q]); a[q].y = bfhi(ov[q]); } }
#pragma unroll 1
        for (int p = 1; p < np; ++p) { const float ml = pm[(size_t)p * 512];
#pragma unroll
            for (int q = 0; q < 8; ++q) ov[q] = *(const unsigned*)(po + (size_t)p * 32768 + q * 128);
#pragma unroll
            for (int q = 0; q < 8; ++q) { const float mp = rdl(ml, q), lp = rdl(ml, 8 + q);
                const float Mn = fmaxf(M[q], mp), w0 = __builtin_amdgcn_exp2f((M[q] - Mn) * C2), w1 = __builtin_amdgcn_exp2f((mp - Mn) * C2);
                L[q] = L[q] * w0 + lp * w1; a[q].x = a[q].x * w0 + bflo(ov[q]) * w1; a[q].y = a[q].y * w0 + bfhi(ov[q]) * w1; M[q] = Mn; } }
#pragma unroll
        for (int q = 0; q < 8; ++q) { const float inv = __builtin_amdgcn_rcpf(L[q]);
            *(unsigned*)(HF + (size_t)(row0 + q) * 2048 + h * 128 + 2 * lane) = pk2(a[q].x * inv * sigm(bflo(gz[q])), a[q].y * inv * sigm(bfhi(gz[q]))); }
    }
}

__device__ __forceinline__ void ph9_router(const Frame& F, const Args& A) {
    unsigned char* ws = A.ws;
    const float* X1 = A.out; const float* g2n = A.in[I_N2G]; const float* MOD = (const float*)(ws + WS_MOD); const float* WRT = (const float*)(ws + WS_WRT); const float* br = A.in[I_BR];
    unsigned char* XGE = (unsigned char*)(ws + WS_XGE); float* SWE = (float*)(ws + WS_SWE); int* EIDX = (int*)(ws + WS_EIDX); int* ESLOT = (int*)(ws + WS_ESLOT);
    unsigned* CNT = (unsigned*)(ws + WS_CTL) + CW_CNT;
    LAS f32x4* wl = (LAS f32x4*)(F.lds + RING_OFF);
    LAS unsigned* cntL = (LAS unsigned*)(F.lds + LDSCTL_OFF + 1280);
    LAS unsigned* baseL = cntL + 32;
    for (int grp = F.vcu; grp < S_ / 32; grp += F.G) {
        int lane = F.lane; asm volatile("" : "+v"(lane));
        const int tid = F.wave * 64 + lane;
        const int r0 = grp * 32 + F.wave * 4;
        if (tid < 32) cntL[tid] = 0u;
        f32x4 hv[4][8];
        { f32x4 t16[16];
#pragma unroll
          for (int i = 0; i < 16; ++i) t16[i] = ((const f32x4*)WRT)[tid + 512 * i];
          __builtin_amdgcn_sched_barrier(0);
#pragma unroll
          for (int r = 0; r < 4; ++r) { const f32x4* xr = (const f32x4*)(X1 + (size_t)(r0 + r) * DM) + lane;
#pragma unroll
              for (int j = 0; j < 8; ++j) hv[r][j] = xr[64 * j]; }
          __builtin_amdgcn_sched_barrier(0);
#pragma unroll
          for (int i = 0; i < 16; ++i) wl[tid + 512 * i] = t16[i]; }
        float rstd[4];
#pragma unroll
        for (int r = 0; r < 4; ++r) { float ss = 0.f;
#pragma unroll
            for (int j = 0; j < 8; ++j) ss += (hv[r][j].x * hv[r][j].x + hv[r][j].y * hv[r][j].y) + (hv[r][j].z * hv[r][j].z + hv[r][j].w * hv[r][j].w);
            rstd[r] = 1.f / sqrtf(wave_sum(ss) * (1.f / DM) + EPS_); }
#pragma unroll
        for (int j = 0; j < 8; ++j) { const int col = 4 * lane + 256 * j;
            const f32x4 g = *(const f32x4*)(g2n + col), sh = *(const f32x4*)(MOD + 6144 + col), sc = *(const f32x4*)(MOD + 8192 + col);
            const f32x4 gs1 = g * (sc + 1.f);
#pragma unroll
            for (int r = 0; r < 4; ++r) hv[r][j] = hv[r][j] * rstd[r] * gs1 + sh;
            __builtin_amdgcn_sched_barrier(0); }
        float lgv[2];
#pragma unroll 1
        for (int half = 0; half < 2; ++half) {
            if (half == 1) { __syncthreads();
              const f32x4* src = (const f32x4*)(WRT + (size_t)16 * DM);
#pragma unroll 1
              for (int i0 = 0; i0 < 16; i0 += 8) { f32x4 t8[8];
#pragma unroll
                for (int i = 0; i < 8; ++i) t8[i] = src[tid + 512 * (i0 + i)];
#pragma unroll
                for (int i = 0; i < 8; ++i) wl[tid + 512 * (i0 + i)] = t8[i]; } }
            __syncthreads();
            float mine = 0.f;
            const bool b0 = lane & 1, b1 = lane & 2, b4 = lane & 16, b5 = lane & 32;
#pragma unroll 1
            for (int g = 0; g < 4; ++g) { float q[4][4];
#pragma unroll
                for (int el = 0; el < 4; ++el) { f32x4 a0 = {0.f, 0.f, 0.f, 0.f}, a1 = a0, a2 = a0, a3 = a0;
#pragma unroll
                    for (int j = 0; j < 8; ++j) { const f32x4 w = wl[(4 * g + el) * 512 + lane + 64 * j];
                        a0 += hv[0][j] * w; a1 += hv[1][j] * w; a2 += hv[2][j] * w; a3 += hv[3][j] * w; }
                    q[0][el] = (a0.x + a0.y) + (a0.z + a0.w); q[1][el] = (a1.x + a1.y) + (a1.z + a1.w); q[2][el] = (a2.x + a2.y) + (a2.z + a2.w); q[3][el] = (a3.x + a3.y) + (a3.z + a3.w); }
                float s1[2][4], s2[4], s3[2];
#pragma unroll
                for (int k = 0; k < 2; ++k)
#pragma unroll
                    for (int el = 0; el < 4; ++el) { const float keep = b4 ? q[2 * k + 1][el] : q[2 * k][el], send = b4 ? q[2 * k][el] : q[2 * k + 1][el]; s1[k][el] = keep + __shfl_xor(send, 16); }
#pragma unroll
                for (int el = 0; el < 4; ++el) { const float keep = b5 ? s1[1][el] : s1[0][el], send = b5 ? s1[0][el] : s1[1][el]; s2[el] = keep + __shfl_xor(send, 32); }
#pragma unroll
                for (int k = 0; k < 2; ++k) { const float keep = b0 ? s2[2 * k + 1] : s2[2 * k], send = b0 ? s2[2 * k] : s2[2 * k + 1]; s3[k] = keep + __shfl_xor(send, 1); }
                float s4; { const float keep = b1 ? s3[1] : s3[0], send = b1 ? s3[0] : s3[1]; s4 = keep + __shfl_xor(send, 2); }
                s4 += __shfl_xor(s4, 4); s4 += __shfl_xor(s4, 8);
                if (((lane >> 2) & 3) == g) mine = s4; }
            const float tot = mine + br[half * 16 + (lane & 15)];
            if (half == 0) lgv[0] = tot; else lgv[1] = tot;
        }
        unsigned pk[4][8];
#pragma unroll
        for (int r = 0; r < 4; ++r)
#pragma unroll
            for (int j = 0; j < 8; ++j) pk[r][j] = pg8::pack_fp8x4(hv[r][j].x, hv[r][j].y, hv[r][j].z, hv[r][j].w);
        float va = lgv[0], vb = lgv[1]; float tv[4]; int ti[4];
#pragma unroll
        for (int k = 0; k < 4; ++k) { float bv = va >= vb ? va : vb; int bi = va >= vb ? (lane & 15) : 16 + (lane & 15);
#pragma unroll
            for (int o = 1; o < 16; o <<= 1) { const float ov = __shfl_xor(bv, o); const int oi = __shfl_xor(bi, o); const bool take = (ov > bv) || (ov == bv && oi < bi); bv = take ? ov : bv; bi = take ? oi : bi; }
            tv[k] = bv; ti[k] = bi; if ((bi & 15) == (lane & 15)) { if (bi < 16) va = -INFINITY; else vb = -INFINITY; } }
        const float e1 = expf(tv[1] - tv[0]), e2 = expf(tv[2] - tv[0]), e3 = expf(tv[3] - tv[0]); const float inv = 1.f / (1.f + e1 + e2 + e3);
        const float wv[4] = {inv, e1 * inv, e2 * inv, e3 * inv};
        unsigned lr[4] = {0u, 0u, 0u, 0u};
        const bool leader = (lane & 15) == 0;
        __syncthreads();
        if (leader) {
#pragma unroll
            for (int k = 0; k < 4; ++k) lr[k] = __hip_atomic_fetch_add(cntL + ti[k], 1u, __ATOMIC_RELAXED, __HIP_MEMORY_SCOPE_WORKGROUP); }
        __syncthreads();
        if (tid < 32) baseL[tid] = __hip_atomic_fetch_add(CNT + 64 * tid, cntL[tid], __ATOMIC_RELAXED, __HIP_MEMORY_SCOPE_AGENT);
        __syncthreads();
        int gs[4];
#pragma unroll
        for (int k = 0; k < 4; ++k) gs[k] = (int)(baseL[ti[k]] + lr[k]);
        if (leader) { const int row = r0 + (lane >> 4);
#pragma unroll
            for (int k = 0; k < 4; ++k) { EIDX[row * 4 + k] = ti[k]; ESLOT[row * 4 + k] = gs[k]; SWE[(size_t)ti[k] * 8192 + gs[k]] = wv[k]; } }
#pragma unroll
        for (int r = 0; r < 4; ++r) {
#pragma unroll
            for (int k = 0; k < 4; ++k) { const int e = __shfl(ti[k], 16 * r), sl = __shfl(gs[k], 16 * r);
                unsigned* o4 = (unsigned*)(XGE + ((size_t)e * 8448 + sl) * DM) + lane;
#pragma unroll
                for (int j = 0; j < 8; ++j) o4[64 * j] = pk[r][j]; } }
        __syncthreads();
    }
}

__device__ __forceinline__ void moe_tables(const Frame& F, const Args& A) {
    LAS int* EOFF = (LAS int*)(F.lds + EOFF_OFF); LAS int* TE = (LAS int*)(F.lds + TILE_E_OFF);
    if (F.wave == 0) {
        const unsigned* CNT = (const unsigned*)(A.ws + WS_CTL) + CW_CNT; const int e = F.lane;
        const int cnt = e < 32 ? (int)__hip_atomic_load(CNT + 64 * e, __ATOMIC_RELAXED, __HIP_MEMORY_SCOPE_AGENT) : 0;
        const int rem = cnt & 255, nf = (cnt >> 8) + (rem > 128 ? 1 : 0), nh = (rem > 0 && rem <= 128) ? 1 : 0, r128 = 2 * nf + nh;
        const int irow = (int)wave_scan_add((float)r128, e), ifull = (int)wave_scan_add((float)nf, e), ihalf = (int)wave_scan_add((float)nh, e);
        const int NF = __shfl(ifull, 63);
        if (e < 32) { EOFF[e] = (irow - r128) * 128;
            for (int i = 0; i < nf; ++i) TE[ifull - nf + i] = e | ((2 * i) << 9);
            if (nh) TE[NF + ihalf - 1] = e | (1 << 8) | ((2 * nf) << 9); }
        if (e == 63) { EOFF[32] = irow * 128; EOFF[33] = ifull + ihalf; }
    }
    __syncthreads();
}
__device__ __forceinline__ void ph13_final(const Frame& F, const Args& A) {
    unsigned char* ws = A.ws;
    const LAS int* EOFF = (const LAS int*)(F.lds + EOFF_OFF);
    const float* MOD = (const float*)(ws + WS_MOD); const float* fg = A.in[I_FNG]; const unsigned char* YS = ws + WS_YS;
    const int* EIDX = (const int*)(ws + WS_EIDX); const int* ESLOT = (const int*)(ws + WS_ESLOT); float* out = A.out;
    const int gw = F.vcu * NWAVES + F.wave, NGW = F.G * NWAVES, lane = F.lane;
    for (int row = gw; row < S_; row += NGW) {
        f32x4 v[8], mo[8];
        const f32x4* xr = (const f32x4*)(out + (size_t)row * DM) + lane;
#pragma unroll
        for (int j = 0; j < 8; ++j) { v[j] = xr[64 * j]; mo[j] = (f32x4){0.f, 0.f, 0.f, 0.f}; }
#pragma unroll
        for (int k = 0; k < 4; ++k) { const int dst = EOFF[EIDX[row * 4 + k]] + ESLOT[row * 4 + k]; const unsigned* yr = (const unsigned*)(YS + (size_t)dst * DM) + lane;
#pragma unroll
            for (int j = 0; j < 8; ++j) { const unsigned w = yr[64 * j]; const auto lo2 = __builtin_amdgcn_cvt_pk_f32_fp8((int)w, false), hi2 = __builtin_amdgcn_cvt_pk_f32_fp8((int)w, true);
                mo[j].x += lo2[0]; mo[j].y += lo2[1]; mo[j].z += hi2[0]; mo[j].w += hi2[1]; } }
        float ss = 0.f;
#pragma unroll
        for (int j = 0; j < 8; ++j) { const f32x4 g2 = *(const f32x4*)(MOD + 10240 + 4 * lane + 256 * j) * 0.03125f; v[j] = v[j] + g2 * mo[j];
            ss += (v[j].x * v[j].x + v[j].y * v[j].y) + (v[j].z * v[j].z + v[j].w * v[j].w); }
        const float rstd = 1.f / sqrtf(wave_sum(ss) * (1.f / DM) + EPS_);
        f32x4* orow = (f32x4*)(out + (size_t)row * DM) + lane;
#pragma unroll
        for (int j = 0; j < 8; ++j) { const f32x4 g = *(const f32x4*)(fg + 4 * lane + 256 * j); orow[64 * j] = v[j] * rstd * g; }
    }
}

#ifndef PG8_SP2
#define PG8_SP2 true
#endif
#ifndef PG8_ALIGN
#define PG8_ALIGN true
#endif
__global__ void __launch_bounds__(NWAVES * 64, 2) mk_fwd(Args args) {
    extern __shared__ __attribute__((aligned(16))) unsigned char lds[];
    Frame F;
    F.lds = (LAS unsigned char*)lds;
    F.tid = threadIdx.x; F.lane = F.tid & 63; F.wave = __builtin_amdgcn_readfirstlane(F.tid >> 6);
    F.G = gridDim.x; { const int bx = blockIdx.x; F.vcu = (F.G % 8 == 0) ? (bx % 8) * (F.G / 8) + bx / 8 : bx; }
    unsigned char* ws = args.ws;
    for (int u = F.tid; u < (LDS_BYTES - LDSCTL_OFF) / 4; u += NWAVES * 64) ((LAS unsigned*)(F.lds + LDSCTL_OFF))[u] = 0u;
    __syncthreads();
    XcdBarrier bar; bar.bar = (unsigned*)(ws + WS_CTL) + CW_BAR; bar.x = 0; bar.st = nullptr;
    if (N_LAUNCHES == 1) bar = xcd_barrier_post((unsigned*)(ws + WS_CTL) + CW_BAR, (volatile LAS unsigned*)(F.lds + MISC_OFF) + 8);
    const int lo = args.ph_lo, hi = args.ph_hi;
#ifdef MK_ONLY
#define IN(k) ((k) == MK_ONLY && lo <= (k) && (k) < hi)
#else
#define IN(k) (lo <= (k) && (k) < hi)
#endif
#define SEAM(k) do { if (IN(k) && IN((k) + 1 + ((k) == 9))) xcd_barrier(bar); } while (0)
#define FENCE_IDS() do { int t_ = threadIdx.x; asm volatile("" : "+v"(t_)); F.tid = t_; F.lane = t_ & 63; } while (0)

    if (IN(0)) { FENCE_IDS(); ph0_prologue(F, args); } SEAM(0);
    if (IN(1)) { FENCE_IDS(); ph1_modreduce(F, args); } SEAM(1);
    if (IN(2)) { FENCE_IDS(); ph2_norm1(F, args); } SEAM(2);
    if (IN(3)) { FENCE_IDS();
        const int gw3 = (F.G == 256) ? GW3 : F.G;
        if ((int)blockIdx.x < gw3) {
            { pg8::Gemm g{(const pg8::bf16_t*)(ws + WS_XN), (const pg8::bf16_t*)(ws + WS_WINT), S_, NZT, DM}; pg8::InOrderBf S; S.init(S_, 21 * 256, gw3, (int)blockIdx.x);
              pg8::EpiZ E{(pg8::bf16_t*)(ws + WS_Z), (float*)(ws + WS_G24), 1.f};
              pg8::gemm_phase<pg8::EpiZ, pg8::InOrderBf, PG8_ALIGN, PG8_SP2>(F.lds + RING_OFF, g, S, E); }
            { pg8::Gemm g{(const pg8::bf16_t*)(ws + WS_XN8), (const pg8::bf16_t*)(ws + WS_WINT8), S_, NZT, DM}; pg8::InOrderF8 S; S.init(S_, 24 * 256, gw3, (int)blockIdx.x);
              pg8::EpiZ E{(pg8::bf16_t*)(ws + WS_Z), (float*)(ws + WS_G24), 0.015625f};
              pg8::gemm_phase<pg8::EpiZ, pg8::InOrderF8, PG8_ALIGN, PG8_SP2, true>(F.lds + RING_OFF, g, S, E); }
        }
        moe_convert_queue(F, args);
    } SEAM(3);
    if (IN(4)) { FENCE_IDS(); for (int u = F.vcu; u < 1024; u += F.G) ph4_unit(F, args, u >> 3, u & 7); } SEAM(4);
    if (IN(5)) { FENCE_IDS();
        ph5_tables(F, args); ph5_m2(F, args); ph5_attention(F, args, (char*)lds);
    } SEAM(5);
    if (IN(6)) { FENCE_IDS(); for (int u = F.vcu; u < 1024; u += F.G) ph6_unit(F, args, u >> 3, u & 7); ph6_hf(F, args); } SEAM(6);
    if (IN(7)) { FENCE_IDS();
        pg8::Gemm g{(const pg8::bf16_t*)(ws + WS_HMF), (const pg8::bf16_t*)(ws + WS_WMT), S_, DM, 2048}; pg8::StaticOrder S; S.init(S_, DM, F.G, (int)blockIdx.x);
        pg8::EpiBranch E{(pg8::bf16_t*)(ws + WS_Y), (const pg8::bf16_t*)(ws + WS_Z), 7168, 9216};
        pg8::gemm_phase<pg8::EpiBranch, pg8::StaticOrder, PG8_ALIGN, PG8_SP2>(F.lds + RING_OFF, g, S, E);
    } SEAM(7);
    if (IN(8)) { FENCE_IDS();
        pg8::Gemm g{(const pg8::bf16_t*)(ws + WS_Y), (const pg8::bf16_t*)(ws + WS_WOUTT), S_, DM, DM}; pg8::StaticOrder S; S.init(S_, DM, F.G, (int)blockIdx.x);
        pg8::EpiResF32 E{args.out, args.in[I_X], (const float*)(ws + WS_MOD) + 4096};
        pg8::gemm_phase<pg8::EpiResF32, pg8::StaticOrder, PG8_ALIGN, PG8_SP2>(F.lds + RING_OFF, g, S, E);
    } SEAM(8);
    if (IN(9)) { FENCE_IDS(); ph9_router(F, args); } SEAM(9);
    if (IN(11)) { FENCE_IDS();
        moe_tables(F, args);
        const int nt = __builtin_amdgcn_readfirstlane(((const LAS int*)(F.lds + EOFF_OFF))[33]);
        pg8::Gemm g{(const pg8::bf16_t*)(ws + WS_XGE), (const pg8::bf16_t*)(ws + WS_WGUT), MPAD, 32 * 4096, DM};
        pg8::MoeOrder S{(const PG8_LAS int*)(F.lds + TILE_E_OFF), (const PG8_LAS int*)(F.lds + EOFF_OFF), nt, 16, F.G, (int)blockIdx.x, true};
        pg8::EpiSwiglu E{(unsigned char*)(ws + WS_ACT), args.in[I_BGU]};
        pg8::gemm_phase<pg8::EpiSwiglu, pg8::MoeOrder, PG8_ALIGN, PG8_SP2, true>(F.lds + RING_OFF, g, S, E);
    } SEAM(11);
    if (IN(12)) { FENCE_IDS();
        if (!IN(11)) moe_tables(F, args);
        const int nt = __builtin_amdgcn_readfirstlane(((const LAS int*)(F.lds + EOFF_OFF))[33]);
        pg8::Gemm g{(const pg8::bf16_t*)(ws + WS_ACT), (const pg8::bf16_t*)(ws + WS_WDT), MPAD, 32 * 2048, DFF};
        pg8::MoeOrder S{(const PG8_LAS int*)(F.lds + TILE_E_OFF), (const PG8_LAS int*)(F.lds + EOFF_OFF), nt, 8, F.G, (int)blockIdx.x, false};
        pg8::EpiDown E{(unsigned char*)(ws + WS_YS), args.in[I_BD], (const float*)(ws + WS_SWE), (const PG8_LAS int*)(F.lds + EOFF_OFF)};
        pg8::gemm_phase<pg8::EpiDown, pg8::MoeOrder, PG8_ALIGN, PG8_SP2, true>(F.lds + RING_OFF, g, S, E);
    } SEAM(12);
    if (IN(13)) { FENCE_IDS(); if (!IN(12)) moe_tables(F, args); ph13_final(F, args); }
#undef IN
#undef SEAM
}

extern "C" void kernel_launch(void* const* d_in, const int* in_sizes, int n_in, void* d_out, int out_size, void* d_ws, size_t ws_size, hipStream_t stream) {
    static int grid = 0;
    if (grid == 0) {
        if (n_in != 25 || in_sizes[0] != S_ * DM || out_size != S_ * DM || ws_size < WS_END) {
            fprintf(stderr, "kernel_launch: unexpected shapes (n_in %d, in0 %d, out %d, ws %zu); nothing launched\n", n_in, n_in > 0 ? in_sizes[0] : -1, out_size, ws_size); grid = -1; return; }
        int dev = 0, cus = 0, per_cu = 0;
        if (hipGetDevice(&dev) != hipSuccess || hipDeviceGetAttribute(&cus, hipDeviceAttributeMultiprocessorCount, dev) != hipSuccess) { grid = -1; return; }
        if (hipFuncSetAttribute((const void*)mk_fwd, hipFuncAttributeMaxDynamicSharedMemorySize, LDS_BYTES) != hipSuccess) { fprintf(stderr, "kernel_launch: hipFuncSetAttribute failed\n"); grid = -1; return; }
        if (hipOccupancyMaxActiveBlocksPerMultiprocessor(&per_cu, (const void*)mk_fwd, NWAVES * 64, LDS_BYTES) != hipSuccess || per_cu < 1)
            fprintf(stderr, "kernel_launch: note: occupancy query reports %d workgroups per CU\n", per_cu);
        (void)hipGetLastError();
        grid = cus;
    }
    if (grid < 0) return;
    if (hipMemsetAsync((char*)d_ws + WS_CTL, 0, CTL_ZERO_BYTES, stream) != hipSuccess) return;
    Args a{};
    for (int i = 0; i < 25; ++i) a.in[i] = (const float*)d_in[i];
    a.out = (float*)d_out; a.ws = (unsigned char*)d_ws;
    if (N_LAUNCHES == 1) { a.ph_lo = 0; a.ph_hi = NPH; hipLaunchKernelGGL(mk_fwd, dim3(grid), dim3(NWAVES * 64), LDS_BYTES, stream, a); }
    else { for (int p = 0; p < NPH; ++p) { a.ph_lo = p; a.ph_hi = p + 1; const int reps = (p == MK_REP_PHASE) ? 3 : 1;
            for (int r = 0; r < reps; ++r) { if (p == 9 && reps > 1) hipMemsetAsync((char*)d_ws + WS_CTL + CW_CNT * 4, 0, 32 * 256, stream);
                hipLaunchKernelGGL(mk_fwd, dim3(grid), dim3(NWAVES * 64), LDS_BYTES, stream, a); } } }
}
```

```cpp
#include <hip/hip_runtime.h>
#include <hip/hip_bf16.h>
#include <cstdio>
#include <cstdint>
#include <cmath>

#ifndef MK_N_LAUNCHES
#define MK_N_LAUNCHES 1
#endif
#ifndef MK_REP_PHASE
#define MK_REP_PHASE -1
#endif

namespace pg8 {
#define PG8_LAS __attribute__((address_space(3)))
typedef unsigned short bf16_t;
typedef short bf16x8 __attribute__((ext_vector_type(8)));
typedef float f32x4 __attribute__((ext_vector_type(4)));
typedef unsigned u32x4 __attribute__((ext_vector_type(4)));
constexpr int BM = 256, BK = 64, HALF = 128, HTB = HALF * BK * 2  , STAGE_BYTES = 8 * HTB, NXCD = 8, WGM = 8;

__host__ __device__ __forceinline__ int lds_byte(int r, int c) { const int st = (r >> 4) * 2 + (c >> 5), rr = r & 15, cc = c & 31, ob = rr * 64 + cc * 2; return st * 1024 + (ob ^ (((ob >> 9) & 1) << 5)); }
__host__ __device__ __forceinline__ void stage_rc(int b, int& R, int& C) { const int st = b / 1024, sb = b % 1024, swz = sb ^ (((sb >> 9) & 1) << 5); R = (st >> 1) * 16 + swz / 64; C = (st & 1) * 32 + (swz % 64) / 2; }
__host__ __device__ __forceinline__ int perm32(int rho) { const int n = rho >> 4, i = rho & 15; return 8 * (i >> 2) + 4 * n + (i & 3); }

struct Unit { int pm, pn, pa, half; };
struct Gemm { const bf16_t* A; const bf16_t* Bt; int M, N, K; };

struct StaticOrder {
    static constexpr bool ROW128 = false;
    int nM, nN, nwg, G, c;
    __host__ __device__ void init(int M, int N, int G_, int c_) { nM = M / BM; nN = N / BM; nwg = nM * nN; G = G_; c = c_; }
    __host__ __device__ bool next(int i, Unit& u) const {
        const long L = (long)i * G + c; if (L >= nwg) return false;
        int wgid = (int)L; { const int q = nwg / NXCD, r = nwg % NXCD, xcd = wgid % NXCD, off = wgid / NXCD; wgid = (xcd < r ? xcd * (q + 1) : r * (q + 1) + (xcd - r) * q) + off; }
        const int nig = WGM * nN, gid = wgid / nig, fm = gid * WGM, gsz = (nM - fm) < WGM ? (nM - fm) : WGM;
        u.pm = fm + ((wgid % nig) % gsz); u.pn = (wgid % nig) / gsz; u.pa = u.pm; u.half = 0; return true;
    }
    __device__ __forceinline__ void a_ready(const Unit&) const {}
    __device__ __forceinline__ void done(const Unit&) const {}
};

__device__ __forceinline__ unsigned cvt_pk_bf16(float lo, float hi) { unsigned r; asm volatile("v_cvt_pk_bf16_f32 %0, %1, %2" : "=v"(r) : "v"(lo), "v"(hi)); return r; }
typedef float f32x2 __attribute__((ext_vector_type(2)));
__device__ __forceinline__ f32x2 gelu_pk(f32x2 v) {
    const f32x2 av = __builtin_elementwise_abs(v), d = av * 0.2316418882f + 1.0f;
    f32x2 t; t.x = __builtin_amdgcn_rcpf(d.x); t.y = __builtin_amdgcn_rcpf(d.y);
    f32x2 q = t * 0.5307027145f + (-0.7265760135f); q = q * t + 0.7107068705f; q = q * t + (-0.142248368f); q = q * t + 0.127414796f; q = q * t;
    const f32x2 s = (v * v) * (-0.72134752044f);
    f32x2 e; e.x = __builtin_amdgcn_exp2f(s.x); e.y = __builtin_amdgcn_exp2f(s.y);
    const f32x2 m = v * (q * e), r = v - m;
    f32x2 o; o.x = v.x < 0.f ? m.x : r.x; o.y = v.y < 0.f ? m.y : r.y; return o;
}

template <int ACT  > struct EpiBf16 {
    static constexpr bool PERM = true, AFTER_DRAIN = false, HAS_MID = false; static_assert(ACT == 0 || ACT == 1, "EpiBf16: ACT is 0 (none) or 1 (gelu_pk)");
    bf16_t* O; int ldc; const float* bias; int split_cols; size_t split_stride; float scale0;
    __device__ __forceinline__ void operator()(const f32x4 (&acc)[2][2][4][2], const Unit& u, int wr, int wc, int fr, int fq) const {
        const int row0 = u.pm * BM + wr * 64 + fr; int colt = u.pn * BM; bf16_t* base = O;
        float sc = 1.f; if (split_cols) { const int t = colt / split_cols; base += (size_t)t * split_stride; colt -= t * split_cols; if (t == 0) sc = scale0; }
        const int col0 = colt + wc * 32 + 8 * fq, bcol0 = u.pn * BM + wc * 32 + 8 * fq;
        f32x4 bv[2][2];
#pragma unroll
        for (int bj = 0; bj < 2; ++bj)
#pragma unroll
            for (int n = 0; n < 2; ++n) bv[bj][n] = bias ? *(const f32x4*)(bias + bcol0 + bj * HALF + 4 * n) : (f32x4){0.f, 0.f, 0.f, 0.f};
#pragma unroll
        for (int ai = 0; ai < 2; ++ai)
#pragma unroll
            for (int m = 0; m < 4; ++m) { bf16_t* rowp = base + (size_t)(row0 + ai * HALF + m * 16) * ldc + col0;
#pragma unroll
                for (int bj = 0; bj < 2; ++bj) { f32x4 v0 = acc[ai][bj][m][0] + bv[bj][0], v1 = acc[ai][bj][m][1] + bv[bj][1];
                    if (ACT == 1) { f32x2 a = gelu_pk((f32x2){v0[0], v0[1]}), b = gelu_pk((f32x2){v0[2], v0[3]}), c = gelu_pk((f32x2){v1[0], v1[1]}), d = gelu_pk((f32x2){v1[2], v1[3]});
                        v0 = (f32x4){a.x, a.y, b.x, b.y}; v1 = (f32x4){c.x, c.y, d.x, d.y}; }
                    v0 = v0 * sc; v1 = v1 * sc; u32x4 w; w.x = cvt_pk_bf16(v0[0], v0[1]); w.y = cvt_pk_bf16(v0[2], v0[3]); w.z = cvt_pk_bf16(v1[0], v1[1]); w.w = cvt_pk_bf16(v1[2], v1[3]);
                    *(u32x4*)(rowp + bj * HALF) = w; } }
    }
};
__device__ __forceinline__ float bf2f(unsigned short h) { return __builtin_bit_cast(float, (unsigned)h << 16); }
__device__ __forceinline__ float sigmoidf_(float x) { return __builtin_amdgcn_rcpf(1.f + __builtin_amdgcn_exp2f(-1.4426950408889634f * x)); }
constexpr int ZLD = 11264;
constexpr int Z8LD = 6144;
__device__ __forceinline__ unsigned pack_fp8x4(float a, float b, float c, float d) { int w = __builtin_amdgcn_cvt_pk_fp8_f32(a, b, 0, false); w = __builtin_amdgcn_cvt_pk_fp8_f32(c, d, w, true); return (unsigned)w; }
struct EpiZ {
    static constexpr bool PERM = true, AFTER_DRAIN = false, HAS_MID = false;
    bf16_t* Z; float* G24; float sc; unsigned char* Z8;
    __device__ __forceinline__ void operator()(const f32x4 (&acc)[2][2][4][2], const Unit& u, int wr, int wc, int fr, int fq) const {
        const int row0 = u.pm * BM + wr * 64 + fr;
        if (Z8) {
            const int col0 = (u.pn < 12 ? u.pn - 8 : u.pn - 20) * BM + wc * 32 + 8 * fq;
#pragma unroll
            for (int ai = 0; ai < 2; ++ai)
#pragma unroll
                for (int m = 0; m < 4; ++m) { unsigned char* rowp = Z8 + (size_t)(row0 + ai * HALF + m * 16) * Z8LD + col0;
#pragma unroll
                    for (int bj = 0; bj < 2; ++bj) { const f32x4 v0 = acc[ai][bj][m][0] * sc, v1 = acc[ai][bj][m][1] * sc;
                        uint2 w; w.x = pack_fp8x4(v0[0], v0[1], v0[2], v0[3]); w.y = pack_fp8x4(v1[0], v1[1], v1[2], v1[3]);
                        *(uint2*)(rowp + bj * HALF) = w; } }
        } else if (u.pn < 44) {
            const int col0 = u.pn * BM + wc * 32 + 8 * fq;
#pragma unroll
            for (int ai = 0; ai < 2; ++ai)
#pragma unroll
                for (int m = 0; m < 4; ++m) { bf16_t* rowp = Z + (size_t)(row0 + ai * HALF + m * 16) * ZLD + col0;
#pragma unroll
                    for (int bj = 0; bj < 2; ++bj) { const f32x4 v0 = acc[ai][bj][m][0] * sc, v1 = acc[ai][bj][m][1] * sc;
                        u32x4 w; w.x = cvt_pk_bf16(v0[0], v0[1]); w.y = cvt_pk_bf16(v0[2], v0[3]); w.z = cvt_pk_bf16(v1[0], v1[1]); w.w = cvt_pk_bf16(v1[2], v1[3]);
                        *(u32x4*)(rowp + bj * HALF) = w; } }
        } else if (wc == 0 && fq < 3) {
#pragma unroll
            for (int ai = 0; ai < 2; ++ai)
#pragma unroll
                for (int m = 0; m < 4; ++m) { float* gp = G24 + (size_t)(row0 + ai * HALF + m * 16) * 24 + 8 * fq;
                    *(f32x4*)gp = acc[ai][0][m][0]; *(f32x4*)(gp + 4) = acc[ai][0][m][1]; }
        }
    }
};
struct EpiBranch {
    static constexpr bool PERM = true, AFTER_DRAIN = false, HAS_MID = true;
    bf16_t* Y; const unsigned char* Z8; int zga, zgb;
    static __device__ __forceinline__ float f8(unsigned w, int i) { const auto p = (i & 2) ? __builtin_amdgcn_cvt_pk_f32_fp8((int)w, true) : __builtin_amdgcn_cvt_pk_f32_fp8((int)w, false); return (i & 1) ? p[1] : p[0]; }
    __device__ __forceinline__ void mid(f32x4 (&acc)[2][2][4][2], const Unit& u, int wr, int wc, int fr, int fq) const {
        asm volatile("" : "+v"(fr), "+v"(fq));
        const int row0 = u.pm * BM + wr * 64 + fr, col0 = u.pn * BM + wc * 32 + 8 * fq;
#pragma unroll
        for (int ai = 0; ai < 2; ++ai)
#pragma unroll
            for (int m = 0; m < 4; ++m) { const unsigned char* zr = Z8 + (size_t)(row0 + ai * HALF + m * 16) * Z8LD + col0;
#pragma unroll
                for (int bj = 0; bj < 2; ++bj) { const uint2 ga2 = *(const uint2*)(zr + zga + bj * HALF), gb2 = *(const uint2*)(zr + zgb + bj * HALF);
#pragma unroll
                    for (int n = 0; n < 2; ++n) { f32x4 r; const unsigned wa = n ? ga2.y : ga2.x, wb = n ? gb2.y : gb2.x;
#pragma unroll
                        for (int i = 0; i < 4; ++i) { const float xa = f8(wa, i), xb = f8(wb, i);
                            r[i] = (1.f + __builtin_amdgcn_exp2f(-1.4426950408889634f * fmaxf(xb, -80.f))) * __builtin_amdgcn_rcpf(1.f + __builtin_amdgcn_exp2f(-1.4426950408889634f * fmaxf(xa, -80.f))); }
                        acc[ai][bj][m][n] *= r; } } }
    }
    __device__ __forceinline__ void operator()(const f32x4 (&acc)[2][2][4][2], const Unit& u, int wr, int wc, int fr, int fq) const {
        asm volatile("" : "+v"(fr), "+v"(fq));
        const int row0 = u.pm * BM + wr * 64 + fr, col0 = u.pn * BM + wc * 32 + 8 * fq;
#pragma unroll
        for (int ai = 0; ai < 2; ++ai)
#pragma unroll
            for (int m = 0; m < 4; ++m) { const size_t row = (size_t)(row0 + ai * HALF + m * 16);
#pragma unroll
                for (int bj = 0; bj < 2; ++bj) { const uint2 gb2 = *(const uint2*)(Z8 + row * Z8LD + zgb + col0 + bj * HALF); float y[8];
#pragma unroll
                    for (int n = 0; n < 2; ++n)
#pragma unroll
                        for (int i = 0; i < 4; ++i) { const float xb = f8(n ? gb2.y : gb2.x, i);
                            y[4 * n + i] = acc[ai][bj][m][n][i] * sigmoidf_(fmaxf(xb, -80.f)); }
                    u32x4 w; w.x = cvt_pk_bf16(y[0], y[1]); w.y = cvt_pk_bf16(y[2], y[3]); w.z = cvt_pk_bf16(y[4], y[5]); w.w = cvt_pk_bf16(y[6], y[7]);
                    *(u32x4*)(Y + row * 2048 + col0 + bj * HALF) = w; } }
    }
};
struct EpiResF32 {
    static constexpr bool PERM = false, AFTER_DRAIN = false, HAS_MID = false;
    float* O; const float* X; const float* gate;
    __device__ __forceinline__ void operator()(const f32x4 (&acc)[2][2][4][2], const Unit& u, int wr, int wc, int fr, int fq) const {
        const int row0 = u.pm * BM + wr * 64 + fr, col0 = u.pn * BM + wc * 32 + 4 * fq;
        f32x4 gv[2][2];
#pragma unroll
        for (int bj = 0; bj < 2; ++bj)
#pragma unroll
            for (int n = 0; n < 2; ++n) gv[bj][n] = *(const f32x4*)(gate + col0 + bj * HALF + n * 16);
#pragma unroll
        for (int ai = 0; ai < 2; ++ai)
#pragma unroll
            for (int m = 0; m < 4; ++m) { const size_t row = (size_t)(row0 + ai * HALF + m * 16);
#pragma unroll
                for (int bj = 0; bj < 2; ++bj)
#pragma unroll
                    for (int n = 0; n < 2; ++n) { const int col = col0 + bj * HALF + n * 16;
                        const f32x4 xv = *(const f32x4*)(X + row * 2048 + col);
                        *(f32x4*)(O + row * 2048 + col) = xv + gv[bj][n] * acc[ai][bj][m][n]; } }
    }
};
struct EpiDelta {
    static constexpr bool PERM = true, AFTER_DRAIN = false, HAS_MID = false;
    bf16_t* D; const float* gate;
    __device__ __forceinline__ void operator()(const f32x4 (&acc)[2][2][4][2], const Unit& u, int wr, int wc, int fr, int fq) const {
        const int row0 = u.pm * BM + wr * 64 + fr, col0 = u.pn * BM + wc * 32 + 8 * fq;
        f32x4 gv[2][2];
#pragma unroll
        for (int bj = 0; bj < 2; ++bj)
#pragma unroll
            for (int n = 0; n < 2; ++n) gv[bj][n] = *(const f32x4*)(gate + col0 + bj * HALF + 4 * n);
#pragma unroll
        for (int ai = 0; ai < 2; ++ai)
#pragma unroll
            for (int m = 0; m < 4; ++m) { bf16_t* rowp = D + (size_t)(row0 + ai * HALF + m * 16) * 2048 + col0;
#pragma unroll
                for (int bj = 0; bj < 2; ++bj) { const f32x4 v0 = acc[ai][bj][m][0] * gv[bj][0], v1 = acc[ai][bj][m][1] * gv[bj][1];
                    u32x4 w; w.x = cvt_pk_bf16(v0[0], v0[1]); w.y = cvt_pk_bf16(v0[2], v0[3]); w.z = cvt_pk_bf16(v1[0], v1[1]); w.w = cvt_pk_bf16(v1[2], v1[3]);
                    *(u32x4*)(rowp + bj * HALF) = w; } }
    }
};
struct EpiSwiglu {
    static constexpr bool PERM = true, AFTER_DRAIN = false, HAS_MID = false;
    unsigned char* ACT; const float* bgu;
    __device__ __forceinline__ void operator()(const f32x4 (&acc)[2][2][4][2], const Unit& u, int wr, int wc, int fr, int fq) const {
        asm volatile("" : "+v"(fr), "+v"(fq));
        const int e = u.pn >> 4, j = u.pn & 15, colL = 128 * j + wc * 32 + 8 * fq, row0 = u.pm * HALF + wr * 64 + fr;
        f32x4 bg[2], bu[2];
#pragma unroll
        for (int n = 0; n < 2; ++n) { bg[n] = *(const f32x4*)(bgu + (size_t)e * 4096 + colL + 4 * n); bu[n] = *(const f32x4*)(bgu + (size_t)e * 4096 + 2048 + colL + 4 * n); }
#pragma unroll
        for (int ai = 0; ai < 2; ++ai) if (!(ai == 1 && u.half))
#pragma unroll
            for (int m = 0; m < 4; ++m) { const size_t row = (size_t)(row0 + ai * HALF + m * 16);
                float a[8];
#pragma unroll
                for (int n = 0; n < 2; ++n)
#pragma unroll
                    for (int i = 0; i < 4; ++i) { float g = acc[ai][0][m][n][i] * 0.015625f + bg[n][i], up = acc[ai][1][m][n][i] * 0.015625f + bu[n][i];
                        g = fminf(g, 7.0f); up = fminf(fmaxf(up, -7.0f), 7.0f);
                        a[4 * n + i] = (up + 1.0f) * g * sigmoidf_(1.702f * g); }
                uint2 w; w.x = pack_fp8x4(a[0], a[1], a[2], a[3]); w.y = pack_fp8x4(a[4], a[5], a[6], a[7]);
                *(uint2*)(ACT + row * 2048 + colL) = w; }
    }
};
struct EpiDown {
    static constexpr bool PERM = true, AFTER_DRAIN = false, HAS_MID = false;
    unsigned char* YS; const float* bd; const float* SWE; const PG8_LAS int* eoff;
    __device__ __forceinline__ void operator()(const f32x4 (&acc)[2][2][4][2], const Unit& u, int wr, int wc, int fr, int fq) const {
        asm volatile("" : "+v"(fr), "+v"(fq));
        const int e = u.pn >> 3, j = u.pn & 7, col0 = 256 * j + wc * 32 + 8 * fq, row0 = u.pm * HALF + wr * 64 + fr; const int eoff0 = eoff[e];
        f32x4 bv[2][2];
#pragma unroll
        for (int bj = 0; bj < 2; ++bj)
#pragma unroll
            for (int n = 0; n < 2; ++n) bv[bj][n] = *(const f32x4*)(bd + (size_t)e * 2048 + col0 + bj * HALF + 4 * n);
#pragma unroll
        for (int ai = 0; ai < 2; ++ai) if (!(ai == 1 && u.half))
#pragma unroll
            for (int m = 0; m < 4; ++m) { const size_t row = (size_t)(row0 + ai * HALF + m * 16); const float sw = 32.f * SWE[(size_t)e * 8192 + (row - (size_t)eoff0)];
#pragma unroll
                for (int bj = 0; bj < 2; ++bj) { const f32x4 v0 = (acc[ai][bj][m][0] * 0.015625f + bv[bj][0]) * sw, v1 = (acc[ai][bj][m][1] * 0.015625f + bv[bj][1]) * sw;
                    uint2 w; w.x = pack_fp8x4(v0[0], v0[1], v0[2], v0[3]); w.y = pack_fp8x4(v1[0], v1[1], v1[2], v1[3]);
                    *(uint2*)(YS + row * 2048 + col0 + bj * HALF) = w; } }
    }
};
struct InOrderBf : StaticOrder { __device__ __forceinline__ bool next(int i, Unit& u) const { if (!StaticOrder::next(i, u)) return false; u.pn = u.pn < 8 ? u.pn : (u.pn < 20 ? u.pn + 4 : 44); return true; } };
struct InOrderF8 : StaticOrder { __device__ __forceinline__ bool next(int i, Unit& u) const { if (!StaticOrder::next(i, u)) return false; u.pn = u.pn < 4 ? 8 + u.pn : 20 + u.pn; return true; } };
struct MoeOrder {
    static constexpr bool ROW128 = true;
    const PG8_LAS int* tile_e; const PG8_LAS int* eoff; int ntiles, npn, G, c; bool a_in_region;
    __device__ __forceinline__ bool next(int i, Unit& u) const {
        int t, j;
        if (G == 256) {
            const int x = c & 7, w = c >> 3;
            const int off = (npn == 16 ? 4 * (x >> 1) : 4 * x) + (w >> 3), lgp = npn == 16 ? 4 : 5;
            const int nr = ntiles > off ? (ntiles - off + (1 << lgp) - 1) >> lgp : 0; if (i >= nr) return false;
            const int p = x < nr - 1 ? x : nr - 1, io = i == p ? nr - 1 : (i < p ? i : i - 1);
            const int bI = io * 8 + x; const int R = npn == 16 ? bI >> 1 : bI, jh = npn == 16 ? bI & 1 : 0;
            t = 4 * R + (w >> 3); j = 8 * jh + (w & 7);
        } else { const long L = (long)i * G + c; if (L >= (long)ntiles * npn) return false; t = (int)(L / npn); j = (int)(L % npn); }
        const int te = __builtin_amdgcn_readfirstlane(tile_e[t]);
        const int e = te & 255, r128 = te >> 9; const int p0 = __builtin_amdgcn_readfirstlane(eoff[e]) >> 7;
        u.pm = p0 + r128; u.pn = e * npn + j; u.pa = a_in_region ? e * 66 + r128 : u.pm; u.half = (te >> 8) & 1; return true;
    }
    __device__ __forceinline__ void a_ready(const Unit&) const {}
    __device__ __forceinline__ void done(const Unit&) const {}
};
typedef int v4i_t __attribute__((ext_vector_type(4)));
typedef int v8i_t __attribute__((ext_vector_type(8)));
__device__ __forceinline__ v8i_t cat8(bf16x8 a, bf16x8 b) { const v4i_t x = __builtin_bit_cast(v4i_t, a), y = __builtin_bit_cast(v4i_t, b); return __builtin_shufflevector(x, y, 0, 1, 2, 3, 4, 5, 6, 7); }
template <class Epi, class Sched, bool ALIGN_EPI = false, bool SP2 = false, bool FP8 = false>
__device__ __forceinline__ void gemm_phase(PG8_LAS unsigned char* lds, const Gemm g, const Sched& S, const Epi& E) {
    const int tid = threadIdx.x, wid = __builtin_amdgcn_readfirstlane(tid >> 6), lane = tid & 63, wr = wid >> 2, wc = wid & 3, fr = lane & 15, fq = lane >> 4;
    const int K = g.K, PB = FP8 ? K : 2 * K  , nt = PB / (BK * 2);
    unsigned voffA[2], voffB[2];
#pragma unroll
    for (int i = 0; i < 2; ++i) { int R, C; stage_rc(tid * 16 + i * 8192, R, C); const int Rb = Epi::PERM ? ((R & ~31) + perm32(R & 31)) : R;
        voffA[i] = (unsigned)(R * PB + C * 2); voffB[i] = (unsigned)(Rb * PB + C * 2); }
    const size_t kstep = (size_t)(BK * 2);
    const size_t hstep = (size_t)HALF * PB;
    const size_t tstep = 2 * hstep;
    const unsigned ldsw = (unsigned)wid * 1024u;
    const int aoff = lds_byte(wr * 64 + fr, fq * 8), boff = lds_byte(wc * 32 + fr, fq * 8);
#define PG8_SA(b, h) (((b) * 2 + (h)) * HTB)
#define PG8_SB(b, h) ((4 + (b) * 2 + (h)) * HTB)
#define PG8_STAGE(bufoff, gbase, voff) do { _Pragma("unroll") for (int _i = 0; _i < 2; ++_i) \
        __builtin_amdgcn_global_load_lds((const unsigned*)((const char*)(gbase) + (voff)[_i]), (PG8_LAS unsigned*)(lds + (bufoff) + ldsw + _i * 8192), 16, 0, 0); } while (0)
#define PG8_LDA(dst, b, h) do { if constexpr (FP8) { _Pragma("unroll") for (int m = 0; m < 4; ++m) dst##8[m] = cat8(*(const PG8_LAS bf16x8*)(lds + PG8_SA(b, h) + aoff + m * 2048), *(const PG8_LAS bf16x8*)(lds + PG8_SA(b, h) + aoff + m * 2048 + 1024)); } \
        else { _Pragma("unroll") for (int m = 0; m < 4; ++m) _Pragma("unroll") for (int k = 0; k < 2; ++k) dst[m][k] = *(const PG8_LAS bf16x8*)(lds + PG8_SA(b, h) + aoff + m * 2048 + k * 1024); } } while (0)
#define PG8_LDB(dst, b, h) do { if constexpr (FP8) { _Pragma("unroll") for (int n = 0; n < 2; ++n) dst##8[n] = cat8(*(const PG8_LAS bf16x8*)(lds + PG8_SB(b, h) + boff + n * 2048), *(const PG8_LAS bf16x8*)(lds + PG8_SB(b, h) + boff + n * 2048 + 1024)); } \
        else { _Pragma("unroll") for (int n = 0; n < 2; ++n) _Pragma("unroll") for (int k = 0; k < 2; ++k) dst[n][k] = *(const PG8_LAS bf16x8*)(lds + PG8_SB(b, h) + boff + n * 2048 + k * 1024); } } while (0)
#define PG8_MMA(ai, bj, At, Bt) do { __builtin_amdgcn_s_setprio(1); if constexpr (FP8) { _Pragma("unroll") for (int m = 0; m < 4; ++m) _Pragma("unroll") for (int n = 0; n < 2; ++n) \
        asm volatile("v_mfma_f32_16x16x128_f8f6f4 %0, %1, %2, %0" : "+v"(acc[ai][bj][m][n]) : "v"(Bt##8[n]), "v"(At##8[m])); } \
        else { _Pragma("unroll") for (int m = 0; m < 4; ++m) _Pragma("unroll") for (int n = 0; n < 2; ++n) _Pragma("unroll") for (int k = 0; k < 2; ++k) \
        acc[ai][bj][m][n] = __builtin_amdgcn_mfma_f32_16x16x32_bf16(Bt[n][k], At[m][k], acc[ai][bj][m][n], 0, 0, 0); } __builtin_amdgcn_s_setprio(0); } while (0)
#define PG8_WAIT_V(n) asm volatile("s_waitcnt vmcnt(" #n ")" ::: "memory")
#define PG8_WAIT_L(n) asm volatile("s_waitcnt lgkmcnt(" #n ")" ::: "memory")
#define PG8_BAR __builtin_amdgcn_s_barrier()
#define PG8_SCHED __builtin_amdgcn_sched_barrier(0)
    Unit cur, nxt; int ui = 0;
    if (!S.next(0, cur)) return;
    f32x4 acc[2][2][4][2];
#pragma unroll
    for (int a = 0; a < 2; ++a)
#pragma unroll
        for (int b = 0; b < 2; ++b)
#pragma unroll
            for (int m = 0; m < 4; ++m)
#pragma unroll
                for (int n = 0; n < 2; ++n) acc[a][b][m][n] = (f32x4){0.f, 0.f, 0.f, 0.f};
    bf16x8 At[4][2], B0[2][2], B1[2][2]; v8i_t At8[4], B08[2], B18[2];
    const char* cA = (const char*)g.A + (size_t)cur.pa * (Sched::ROW128 ? hstep : tstep); const char* cB = (const char*)g.Bt + (size_t)cur.pn * tstep;
    S.a_ready(cur);
    if constexpr (SP2) {
        PG8_STAGE(PG8_SB(0, 0), cB, voffB); PG8_STAGE(PG8_SB(0, 1), cB + hstep, voffB); PG8_STAGE(PG8_SA(0, 0), cA, voffA); PG8_STAGE(PG8_SA(0, 1), cA + hstep, voffA);
        if (wr == 1) PG8_BAR;
        PG8_WAIT_V(2); PG8_BAR;
        PG8_STAGE(PG8_SB(1, 0), cB + kstep, voffB); PG8_STAGE(PG8_SA(1, 0), cA + kstep, voffA); PG8_STAGE(PG8_SB(1, 1), cB + hstep + kstep, voffB);
        PG8_WAIT_V(6); PG8_BAR;
    } else {
        PG8_STAGE(PG8_SB(0, 0), cB, voffB); PG8_STAGE(PG8_SA(0, 0), cA, voffA); PG8_STAGE(PG8_SB(0, 1), cB + hstep, voffB); PG8_STAGE(PG8_SA(0, 1), cA + hstep, voffA);
        if (wr == 1) PG8_BAR;
        PG8_WAIT_V(4); PG8_BAR;
        PG8_STAGE(PG8_SB(1, 0), cB + kstep, voffB); PG8_STAGE(PG8_SA(1, 0), cA + kstep, voffA); PG8_STAGE(PG8_SB(1, 1), cB + hstep + kstep, voffB);
        PG8_WAIT_V(6); PG8_BAR;
    }
    for (;;) {
        const bool has_next = S.next(ui + 1, nxt);
        const char* nA = has_next ? (const char*)g.A + (size_t)nxt.pa * (Sched::ROW128 ? hstep : tstep) : cA; const char* nB = has_next ? (const char*)g.Bt + (size_t)nxt.pn * tstep : cB;
        const bool hu = Sched::ROW128 && SP2 && cur.half != 0;
        for (int t = 0; t < nt; t += 2) {
            if constexpr (Epi::HAS_MID) { if (t == nt / 2) { E.mid(acc, cur, wr, wc, fr, fq); PG8_WAIT_V(0); } }
            const bool last = (t == nt - 2);
            const char* a1 = cA + (size_t)(t + 1) * kstep;
            const char* a2 = last ? nA : cA + (size_t)(t + 2) * kstep; const char* b2 = last ? nB : cB + (size_t)(t + 2) * kstep;
            const char* a3 = a2 + kstep; const char* b3 = b2 + kstep;
            if (last && has_next) S.a_ready(nxt);
            if constexpr (SP2) {
            PG8_LDB(B0, 0, 0); PG8_LDB(B1, 0, 1); PG8_SCHED; PG8_LDA(At, 0, 0); PG8_STAGE(PG8_SA(1, 1), a1 + hstep, voffA);
            PG8_WAIT_V(8); PG8_WAIT_L(0); PG8_BAR; PG8_MMA(0, 0, At, B0); PG8_MMA(0, 1, At, B1); PG8_BAR; PG8_SCHED;
            if (!hu) PG8_LDA(At, 0, 1); PG8_STAGE(PG8_SB(0, 0), b2, voffB); PG8_STAGE(PG8_SB(0, 1), b2 + hstep, voffB); PG8_STAGE(PG8_SA(0, 0), a2, voffA);
            PG8_WAIT_V(8); PG8_WAIT_L(0); PG8_BAR; if (!hu) { PG8_MMA(1, 0, At, B0); PG8_MMA(1, 1, At, B1); } PG8_BAR; PG8_SCHED;
            PG8_LDB(B0, 1, 0); PG8_LDB(B1, 1, 1); PG8_SCHED; PG8_LDA(At, 1, 0); PG8_STAGE(PG8_SA(0, 1), a2 + hstep, voffA);
            PG8_WAIT_V(8); PG8_WAIT_L(0); PG8_BAR; PG8_MMA(0, 0, At, B0); PG8_MMA(0, 1, At, B1); PG8_BAR; PG8_SCHED;
            if (!hu) PG8_LDA(At, 1, 1); PG8_STAGE(PG8_SB(1, 0), b3, voffB); PG8_STAGE(PG8_SB(1, 1), b3 + hstep, voffB); PG8_STAGE(PG8_SA(1, 0), a3, voffA);
            PG8_WAIT_V(8); PG8_WAIT_L(0); PG8_BAR; if (!hu) { PG8_MMA(1, 0, At, B0); PG8_MMA(1, 1, At, B1); } PG8_BAR; PG8_SCHED;
            } else {
            PG8_LDB(B0, 0, 0); PG8_SCHED; PG8_LDA(At, 0, 0); PG8_STAGE(PG8_SA(1, 1), a1 + hstep, voffA);
            PG8_WAIT_L(8); PG8_BAR; PG8_WAIT_L(0); PG8_MMA(0, 0, At, B0); PG8_BAR; PG8_SCHED;
            PG8_LDB(B1, 0, 1); PG8_STAGE(PG8_SB(0, 0), b2, voffB);
            PG8_BAR; PG8_WAIT_L(0); PG8_MMA(0, 1, At, B1); PG8_BAR;
            PG8_LDA(At, 0, 1); PG8_STAGE(PG8_SA(0, 0), a2, voffA);
            PG8_BAR; PG8_WAIT_L(0); PG8_MMA(1, 0, At, B0); PG8_BAR; PG8_SCHED;
            PG8_STAGE(PG8_SB(0, 1), b2 + hstep, voffB);
            PG8_WAIT_V(6); PG8_BAR; PG8_MMA(1, 1, At, B1); PG8_BAR;
            PG8_LDB(B0, 1, 0); PG8_SCHED; PG8_LDA(At, 1, 0); PG8_STAGE(PG8_SA(0, 1), a2 + hstep, voffA);
            PG8_WAIT_L(8); PG8_BAR; PG8_WAIT_L(0); PG8_MMA(0, 0, At, B0); PG8_BAR; PG8_SCHED;
            PG8_LDB(B1, 1, 1); PG8_STAGE(PG8_SB(1, 0), b3, voffB);
            PG8_BAR; PG8_WAIT_L(0); PG8_MMA(0, 1, At, B1); PG8_BAR;
            PG8_LDA(At, 1, 1); PG8_STAGE(PG8_SA(1, 0), a3, voffA);
            PG8_BAR; PG8_WAIT_L(0); PG8_MMA(1, 0, At, B0); PG8_BAR; PG8_SCHED;
            PG8_STAGE(PG8_SB(1, 1), b3 + hstep, voffB);
            PG8_WAIT_V(6); PG8_BAR; PG8_MMA(1, 1, At, B1); PG8_BAR;
            }
        }
        if constexpr (ALIGN_EPI) { if (wr == 0) PG8_BAR; }
        if constexpr (FP8) asm volatile("s_nop 15\n\ts_nop 15" ::: "memory");
        if constexpr (!Epi::AFTER_DRAIN) { E(acc, cur, wr, wc, fr, fq); S.done(cur); }
        if (!has_next) break;
#pragma unroll
        for (int a = 0; a < 2; ++a)
#pragma unroll
            for (int b = 0; b < 2; ++b)
#pragma unroll
                for (int m = 0; m < 4; ++m)
#pragma unroll
                    for (int n = 0; n < 2; ++n) acc[a][b][m][n] = (f32x4){0.f, 0.f, 0.f, 0.f};
        cur = nxt; cA = nA; cB = nB; ++ui;
        if constexpr (ALIGN_EPI) { if (wr == 1) PG8_BAR; }
    }
    PG8_WAIT_V(0);
    if constexpr (!ALIGN_EPI) { if (wr == 0) PG8_BAR; }
    PG8_BAR;
    if constexpr (Epi::AFTER_DRAIN) { E.fused(acc, cur, wr, wc, fr, fq, lds, wid, lane); S.done(cur); }
#undef PG8_SA
#undef PG8_SB
#undef PG8_STAGE
#undef PG8_LDA
#undef PG8_LDB
#undef PG8_MMA
#undef PG8_WAIT_V
#undef PG8_WAIT_L
#undef PG8_BAR
#undef PG8_SCHED
}
}

namespace fox {
constexpr int B = 1, H = 8, HKV = 8, SQ = 8192, SKV = 8192, D = 128, QOFF = 0, WINDOW = SKV;
constexpr float THR = 8.f;
constexpr bool WSKIP = false;
constexpr int ATT_QP = 1024, ATT_KP = 1024, ATT_VP = 11264, ATT_OP = 1024;
constexpr int ATT_BIAS_OFF = 69632;
constexpr float SCALE = 0.08838834764831845f;
constexpr int NW = 8, QBLK = 32, KVBLK = 64, QB = NW * QBLK;
constexpr int SHM_V = KVBLK * D * 2, SHM_K = KVBLK * D * 2;
constexpr int LDS_BYTES = 2 * SHM_V + 2 * SHM_K + NW * 64 * 4;
static_assert(D == 128 && SQ % QB == 0 && SKV % KVBLK == 0 && H % HKV == 0 && QOFF >= 0 && QOFF + SQ <= SKV && WINDOW >= 1, "geometry");

using bf16 = __hip_bfloat16;
typedef short bf16x8 __attribute__((ext_vector_type(8)));
typedef short s16x4 __attribute__((ext_vector_type(4)));
typedef float f32x16 __attribute__((ext_vector_type(16)));
typedef float f32x4 __attribute__((ext_vector_type(4)));
typedef unsigned u32x4 __attribute__((ext_vector_type(4)));
template <class A, class Bt> struct same_t { static constexpr bool v = false; };
template <class A> struct same_t<A, A> { static constexpr bool v = true; };

#define KSWZ(row, colB) ((row) * 256 + ((colB) ^ (((row) & 7) << 4)))
#define SBAR() __builtin_amdgcn_sched_barrier(0)
__device__ __forceinline__ int v_st(int k, int c) { const int kk = (k & ~0xC) | ((k & 4) << 1) | ((k & 8) >> 1); return ((kk >> 3) * 4 + (c >> 5)) * 512 + ((kk & 7) * 32 + (c & 31)) * 2; }
__device__ __forceinline__ int v_rd_base(int lane) { return ((lane & 3) << 3) | (((lane >> 2) & 3) << 6) | (((lane >> 4) & 1) << 5) | (((lane >> 5) & 1) << 8); }
constexpr int v_rd_off(int d0, int ks, int half) { return d0 * 512 + ks * 4096 + half * 2048; }
__device__ __forceinline__ int crow(int r, int hi) { return (r & 3) + 8 * (r >> 2) + 4 * hi; }
__device__ __forceinline__ unsigned cvtpk(float lo, float hi) {
    unsigned r; asm volatile("v_cvt_pk_bf16_f32 %0, %1, %2" : "=v"(r) : "v"(lo), "v"(hi)); return r;
}
__device__ __forceinline__ bf16x8 pack8(f32x4 a, f32x4 b) {
    u32x4 w = {cvtpk(a[0], a[1]), cvtpk(a[2], a[3]), cvtpk(b[0], b[1]), cvtpk(b[2], b[3])};
    return *reinterpret_cast<bf16x8*>(&w);
}
template <class T> __device__ __forceinline__ bf16x8 load8(const T* p) {
    if constexpr (same_t<T, float>::v) { return pack8(*(const f32x4*)p, *(const f32x4*)(p + 4)); }
    else { return *reinterpret_cast<const bf16x8*>(p); }
}
__device__ __forceinline__ void mask_tile(f32x16& p0, f32x16& p1, int dq, unsigned W) {
    const float NEG = -__builtin_inff();
#pragma unroll
    for (int r = 0; r < 16; ++r) {
        const int c = (r & 3) + 8 * (r >> 2);
        if ((unsigned)(dq - c) >= W) p0[r] = NEG;
        if ((unsigned)(dq - c - 32) >= W) p1[r] = NEG;
    }
}
__device__ __forceinline__ void partialSM(f32x16& p0, f32x16& p1, float& m_reg, float& mn, float& alpha) {
    float pmax = p0[0]; for (int r = 1; r < 16; ++r) pmax = fmaxf(pmax, p0[r]); for (int r = 0; r < 16; ++r) pmax = fmaxf(pmax, p1[r]);
    { auto rr = __builtin_amdgcn_permlane32_swap(__float_as_uint(pmax), __float_as_uint(pmax), false, false);
      pmax = fmaxf(__uint_as_float(rr[0]), __uint_as_float(rr[1])); }
    constexpr float C2 = 1.4426950408889634f * SCALE;
    if (__builtin_expect(__all((pmax - m_reg) * SCALE <= THR), 1)) { mn = m_reg; alpha = 1.f; }
    else { mn = fmaxf(m_reg, pmax); alpha = __builtin_amdgcn_exp2f((m_reg - mn) * C2); m_reg = mn; }
    const float mnL = -mn * C2;
    for (int r = 0; r < 16; ++r) p0[r] = fmaf(p0[r], C2, mnL); for (int r = 0; r < 16; ++r) p1[r] = fmaf(p1[r], C2, mnL);
    for (int r = 0; r < 16; ++r) p0[r] = __builtin_amdgcn_exp2f(p0[r]);
}
__device__ __forceinline__ void finishSM(f32x16& p0, f32x16& p1, float alpha, float& l_reg, bf16x8& pa0, bf16x8& pa1, bf16x8& pa2, bf16x8& pa3) {
    for (int r = 0; r < 16; ++r) p1[r] = __builtin_amdgcn_exp2f(p1[r]);
    float ps = 0; for (int r = 0; r < 16; ++r) ps += p0[r]; for (int r = 0; r < 16; ++r) ps += p1[r];
    { auto rr = __builtin_amdgcn_permlane32_swap(__float_as_uint(ps), __float_as_uint(ps), false, false);
      ps = __uint_as_float(rr[0]) + __uint_as_float(rr[1]); }
    l_reg = l_reg * alpha + ps;
#define PK4(P, B_, OUT) do { unsigned a0 = cvtpk(P[B_+0], P[B_+1]), a1 = cvtpk(P[B_+2], P[B_+3]);                          \
        unsigned b0 = cvtpk(P[B_+4], P[B_+5]), b1 = cvtpk(P[B_+6], P[B_+7]);                                             \
        auto r0 = __builtin_amdgcn_permlane32_swap(a0, b0, false, false); auto r1 = __builtin_amdgcn_permlane32_swap(a1, b1, false, false); \
        u32x4 w = {r0[0], r1[0], r0[1], r1[1]}; OUT = *reinterpret_cast<bf16x8*>(&w); } while (0)
    PK4(p0, 0, pa0); PK4(p0, 8, pa1); PK4(p1, 0, pa2); PK4(p1, 8, pa3);
#undef PK4
}
template <int KB, bool SK>
__device__ __forceinline__ void qkt(f32x16& p0, f32x16& p1, const char* K_lds, int r32, int hi, const bf16x8* qr, bool act, const float* bl) {
    if (SK && !act) { const float NEG = -__builtin_inff();
#pragma unroll
        for (int r = 0; r < 16; ++r) { p0[r] = NEG; p1[r] = NEG; } return; }
    {
        const f32x4 a0 = *(const f32x4*)(bl), a1 = *(const f32x4*)(bl + 8), a2 = *(const f32x4*)(bl + 16), a3 = *(const f32x4*)(bl + 24);
        const f32x4 c0 = *(const f32x4*)(bl + 32), c1 = *(const f32x4*)(bl + 40), c2 = *(const f32x4*)(bl + 48), c3 = *(const f32x4*)(bl + 56);
        p0 = (f32x16){a0[0], a0[1], a0[2], a0[3], a1[0], a1[1], a1[2], a1[3], a2[0], a2[1], a2[2], a2[3], a3[0], a3[1], a3[2], a3[3]};
        p1 = (f32x16){c0[0], c0[1], c0[2], c0[3], c1[0], c1[1], c1[2], c1[3], c2[0], c2[1], c2[2], c2[3], c3[0], c3[1], c3[2], c3[3]}; }
    const char* kb[4];
#pragma unroll
    for (int dd = 0; dd < 4; ++dd) kb[dd] = K_lds + KB * SHM_K + KSWZ(r32, (dd * 16 + hi * 8) * 2);
#pragma unroll
    for (int d0 = 0; d0 < 8; ++d0) { const char* a = kb[d0 & 3] + (d0 >> 2) * 128;
        bf16x8 b0 = *reinterpret_cast<const bf16x8*>(a);
        bf16x8 b1 = *reinterpret_cast<const bf16x8*>(a + 32 * 256);
        p0 = __builtin_amdgcn_mfma_f32_32x32x16_bf16(b0, qr[d0], p0, 0, 0, 0);
        p1 = __builtin_amdgcn_mfma_f32_32x32x16_bf16(b1, qr[d0], p1, 0, 0, 0); }
}
template <int VB, bool SK>
__device__ __forceinline__ void pv_tile(f32x16* o, int vb0, bf16x8 pa0, bf16x8 pa1, bf16x8 pa2, bf16x8 pa3, bool act) {
    if (SK && !act) return;
#define TRRD(dst, off) asm volatile("ds_read_b64_tr_b16 %0, %1 offset:%2" : "=&v"(dst) : "v"(vb0), "i"(off) : "memory")
#define PV_D0(d0) do { s16x4 l0, l1, l2, l3, h0, h1, h2, h3; constexpr int b_ = VB * SHM_V + v_rd_off(d0, 0, 0);     \
        TRRD(l0, b_); TRRD(h0, b_ + 2048); TRRD(l1, b_ + 4096); TRRD(h1, b_ + 6144); TRRD(l2, b_ + 8192); TRRD(h2, b_ + 10240); TRRD(l3, b_ + 12288); TRRD(h3, b_ + 14336); \
        asm volatile("s_waitcnt lgkmcnt(0)" ::: "memory"); SBAR();                 \
        o[d0] = __builtin_amdgcn_mfma_f32_32x32x16_bf16(pa0, (bf16x8){l0[0], l0[1], l0[2], l0[3], h0[0], h0[1], h0[2], h0[3]}, o[d0], 0, 0, 0);   \
        o[d0] = __builtin_amdgcn_mfma_f32_32x32x16_bf16(pa1, (bf16x8){l1[0], l1[1], l1[2], l1[3], h1[0], h1[1], h1[2], h1[3]}, o[d0], 0, 0, 0);   \
        o[d0] = __builtin_amdgcn_mfma_f32_32x32x16_bf16(pa2, (bf16x8){l2[0], l2[1], l2[2], l2[3], h2[0], h2[1], h2[2], h2[3]}, o[d0], 0, 0, 0);   \
        o[d0] = __builtin_amdgcn_mfma_f32_32x32x16_bf16(pa3, (bf16x8){l3[0], l3[1], l3[2], l3[3], h3[0], h3[1], h3[2], h3[3]}, o[d0], 0, 0, 0); } while (0)
    PV_D0(0); PV_D0(1); PV_D0(2); PV_D0(3);
#undef PV_D0
#undef TRRD
}

template <class TIn, class TOut> struct BlockRef { const TIn* Q; const TIn* K; const TIn* V; TOut* O; int P0; int jlo, jhi; bf16* PO; float* PML; };
template <class TIn> struct Seam {
    bf16x8 qr[8];
    bf16x8 st_v0, st_v1, st_k0, st_k1; f32x4 sf0, sf1, sf2, sf3;
    f32x4 tq[16];
};
__device__ __forceinline__ int swa_jlo(int P0, int W) { const int lowk = P0 - W + 1; return lowk > 0 ? lowk / KVBLK : 0; }
#define ROWK(p, k0, rr) ((p) + (size_t)((k0) + (rr)) * ATT_KP + sc)
#define ROWV(p, k0, rr) ((p) + (size_t)((k0) + (rr)) * ATT_VP + sc)
#define VMW() asm volatile("s_waitcnt vmcnt(0)" ::: "memory")
#define VMWN(n) asm volatile("s_waitcnt vmcnt(%0)" :: "i"(n) : "memory")
#define SLOAD_H(Kp, Vp, k0) do { S.st_v0 = load8<TIn>(ROWV(Vp, k0, sr)); S.st_v1 = load8<TIn>(ROWV(Vp, k0, 32 + sr));              \
                         S.st_k0 = load8<TIn>(ROWK(Kp, k0, sr)); S.st_k1 = load8<TIn>(ROWK(Kp, k0, 32 + sr)); } while (0)
#define SWRITE_HK(bf) do { *(bf16x8*)(K_lds + (bf) * SHM_K + kws) = S.st_k0; *(bf16x8*)(K_lds + (bf) * SHM_K + kws + 32 * 256) = S.st_k1; } while (0)
#define SWRITE_HV(bf) do { *(bf16x8*)(V_lds + (bf) * SHM_V + vst0) = S.st_v0; *(bf16x8*)(V_lds + (bf) * SHM_V + vst1) = S.st_v1; } while (0)
#define SWRITE_H(bf) do { SWRITE_HV(bf); SWRITE_HK(bf); } while (0)
#define SLOAD_F(p, k0) do { S.sf0 = *(const f32x4*)ROWK(p, k0, sr); S.sf1 = *(const f32x4*)(ROWK(p, k0, sr) + 4);                \
                            S.sf2 = *(const f32x4*)ROWK(p, k0, 32 + sr); S.sf3 = *(const f32x4*)(ROWK(p, k0, 32 + sr) + 4); } while (0)
#define SWRITE_KF(bf) do { *(bf16x8*)(K_lds + (bf) * SHM_K + kws) = pack8(S.sf0, S.sf1); *(bf16x8*)(K_lds + (bf) * SHM_K + kws + 32 * 256) = pack8(S.sf2, S.sf3); } while (0)
#define SWRITE_VF(bf) do { *(bf16x8*)(V_lds + (bf) * SHM_V + vst0) = pack8(S.sf0, S.sf1); *(bf16x8*)(V_lds + (bf) * SHM_V + vst1) = pack8(S.sf2, S.sf3); } while (0)
template <class TIn, class TOut>
__device__ __forceinline__ void causal_swa_prime(const BlockRef<TIn, TOut>& cur, int W, char* lds, Seam<TIn>& S) {
    constexpr bool F32 = same_t<TIn, float>::v;
    const int tid = threadIdx.x, wid = __builtin_amdgcn_readfirstlane(tid >> 6), lane = tid & 63, r32 = lane & 31, hi = lane >> 5;
    const int sr = tid >> 4, sc = (tid & 15) * 8, kws = KSWZ(sr, sc * 2); char* K_lds = lds + 2 * SHM_V;
    const int kb0 = cur.jlo * KVBLK;
    for (int d0 = 0; d0 < 8; ++d0) S.qr[d0] = load8<TIn>(cur.Q + (size_t)(wid * QBLK + r32) * ATT_QP + d0 * 16 + hi * 8);
    if constexpr (F32) { SLOAD_F((const float*)cur.K, kb0); VMW(); SWRITE_KF(0); SBAR(); SLOAD_F((const float*)cur.V, kb0); }
    else { SLOAD_H(cur.K, cur.V, kb0); VMW(); SWRITE_HK(0); }
    __syncthreads();
}
template <class TIn, class TOut>
__device__ __forceinline__ void causal_swa_block(const BlockRef<TIn, TOut>& cur, const BlockRef<TIn, TOut>& nxt, int skv, int W, char* lds, Seam<TIn>& S) {
    constexpr bool F32 = same_t<TIn, float>::v;
    const int tid = threadIdx.x, wid = __builtin_amdgcn_readfirstlane(tid >> 6), lane = tid & 63, r32 = lane & 31, hi = lane >> 5;
    const int j_lo = cur.jlo;
    const int j_hi = cur.jhi;
    const int NT = j_hi - j_lo;
    const int kbn = nxt.jlo * KVBLK;
    const int qlo = cur.P0 + wid * QBLK, qm = qlo + r32 - 4 * hi;
    char* V_lds = lds; char* K_lds = lds + 2 * SHM_V;
    float* ws = (float*)(lds + 2 * SHM_V + 2 * SHM_K) + wid * 64; float* li_l = ws, * al_l = ws + 32;
    const float* biasL = (const float*)(lds + ATT_BIAS_OFF);
    float m_reg = -1e30f, l_reg = 0; f32x16 o[4] = {};
    const int sr = tid >> 4, sc = (tid & 15) * 8, vst0 = v_st(sr, sc), vst1 = v_st(32 + sr, sc), kws = KSWZ(sr, sc * 2);
    const int vb0 = (int)(uintptr_t)V_lds + v_rd_base(lane);
    const TIn* Kh = cur.K; const TIn* Vh = cur.V;
#define RESC(a) do { if (__any((a) < 1.f)) { if (hi == 0) al_l[r32] = (a); asm volatile("s_waitcnt lgkmcnt(0)" ::: "memory");              \
                     for (int d_ = 0; d_ < 4; ++d_) for (int r = 0; r < 16; ++r) o[d_][r] *= al_l[crow(r, hi)]; } } while (0)
#define KBASE(t) ((j_lo + (t)) * KVBLK)
#define BIASP(t) (biasL + KBASE(t) + 4 * hi)
#define ACT(t) (KBASE(t) <= qlo + QBLK - 1 && KBASE(t) + KVBLK - 1 >= qlo - W + 1)
#define MASKT(P0_, P1_, t) do { const int kb_ = KBASE(t); if ((!SK || ACT(t)) && (kb_ + KVBLK - 1 > qlo || kb_ <= qlo + QBLK - 1 - W)) mask_tile(P0_, P1_, qm - kb_, (unsigned)W); } while (0)
    constexpr int NQL = F32 ? 16 : 8;
    constexpr bool SK = WSKIP && !F32;
#define SEAM_K0() do { VMWN(NQL); if constexpr (F32) { SWRITE_KF(0); SBAR(); SLOAD_F((const float*)nxt.V, kbn); } else { SWRITE_HK(0); } SBAR(); } while (0)
    f32x16 pA0, pA1, pB0, pB1; float mnA, mnB, alA, alB; bf16x8 pa0, pa1, pa2, pa3;
    if constexpr (F32) { VMW(); SWRITE_VF(0); SBAR(); } else { SWRITE_HV(0); SBAR(); }
    if (NT > 1) { if constexpr (F32) SLOAD_F((const float*)Kh, KBASE(1)); else SLOAD_H(Kh, Vh, KBASE(1)); }
    SBAR(); qkt<0, SK>(pA0, pA1, K_lds, r32, hi, S.qr, ACT(0), BIASP(0));
    if constexpr (F32) { if (NT > 1) { VMW(); SWRITE_KF(1); SBAR(); SLOAD_F((const float*)Vh, KBASE(1)); } }
    MASKT(pA0, pA1, 0); partialSM(pA0, pA1, m_reg, mnA, alA);
    if (NT > 1) { VMW(); if constexpr (F32) { SWRITE_VF(1); SBAR(); if (NT > 2) SLOAD_F((const float*)Kh, KBASE(2)); } else SWRITE_H(1); }
    __syncthreads();
#define HALF_STEP(PX0, PX1, mnX, alX, PY0, PY1, alY, t, KB, VB, SB) do {                                                      \
        SBAR(); qkt<KB, SK>(PX0, PX1, K_lds, r32, hi, S.qr, ACT(t), BIASP(t));                                             \
        finishSM(PY0, PY1, alY, l_reg, pa0, pa1, pa2, pa3); SBAR();                                                           \
        if ((t) + 1 < NT) { if constexpr (F32) { VMW(); SWRITE_KF(SB); SBAR(); SLOAD_F((const float*)Vh, KBASE((t) + 1)); }  \
                            else { SLOAD_H(Kh, Vh, KBASE((t) + 1)); } SBAR(); }                                               \
        pv_tile<VB, SK>(o, vb0, pa0, pa1, pa2, pa3, ACT((t) - 1)); MASKT(PX0, PX1, (t)); partialSM(PX0, PX1, m_reg, mnX, alX);                                        \
        __syncthreads();                                                                                                      \
        if ((t) + 1 < NT) { VMW(); if constexpr (F32) { SWRITE_VF(SB); SBAR(); if ((t) + 2 < NT) SLOAD_F((const float*)Kh, KBASE((t) + 2)); } \
                            else { SWRITE_H(SB); } }                                                                          \
        RESC(alX); __syncthreads(); } while (0)
    for (int t = 1; t + 1 < NT; t += 2) {
        HALF_STEP(pB0, pB1, mnB, alB, pA0, pA1, alA, t, 1, 0, 0);
        HALF_STEP(pA0, pA1, mnA, alA, pB0, pB1, alB, t + 1, 0, 1, 1);
    }
    const bool even = (NT & 1) == 0;
    if (even) { SBAR(); qkt<1, SK>(pB0, pB1, K_lds, r32, hi, S.qr, ACT(NT - 1), BIASP(NT - 1)); SBAR(); }
#define QROW(e) (nxt.Q + (size_t)(wid * QBLK + r32) * ATT_QP + ((e) >> 1) * 16 + hi * 8 + ((e) & 1) * 4)
    if constexpr (F32) { SLOAD_F((const float*)nxt.K, kbn); SBAR();
#pragma unroll
        for (int e = 0; e < 8; ++e) S.tq[e] = *(const f32x4*)QROW(e); }
    else { SLOAD_H(nxt.K, nxt.V, kbn); SBAR();
#pragma unroll
        for (int d0 = 0; d0 < 8; ++d0) S.qr[d0] = load8<TIn>(nxt.Q + (size_t)(wid * QBLK + r32) * ATT_QP + d0 * 16 + hi * 8); }
    SBAR();
    finishSM(pA0, pA1, alA, l_reg, pa0, pa1, pa2, pa3); SBAR();
    if constexpr (F32) {
#pragma unroll
        for (int e = 8; e < 16; ++e) S.tq[e] = *(const f32x4*)QROW(e); SBAR(); }
#undef QROW
    pv_tile<0, SK>(o, vb0, pa0, pa1, pa2, pa3, ACT(even ? NT - 2 : NT - 1));
    if (even) { MASKT(pB0, pB1, NT - 1); partialSM(pB0, pB1, m_reg, mnB, alB); __syncthreads(); RESC(alB);
        finishSM(pB0, pB1, alB, l_reg, pa0, pa1, pa2, pa3); SBAR(); pv_tile<1, SK>(o, vb0, pa0, pa1, pa2, pa3, ACT(NT - 1)); }
    SBAR(); SEAM_K0();
    {
        bf16* Pw = cur.PO + (size_t)(wid * QBLK) * 128;
#pragma unroll
        for (int r = 0; r < 16; ++r) { const int orow = crow(r, hi);
#pragma unroll
            for (int d0 = 0; d0 < 4; ++d0) { const float v = o[d0][r]; const float vn = __shfl_xor(v, 1);
                if ((r32 & 1) == 0) __builtin_nontemporal_store(cvtpk(v, vn), (unsigned*)(Pw + (size_t)orow * 128 + d0 * 32 + r32)); } }
        if (hi == 0) { cur.PML[wid * QBLK + r32] = m_reg; cur.PML[256 + wid * QBLK + r32] = l_reg; }
    }
    if constexpr (F32) {
#pragma unroll
        for (int d0 = 0; d0 < 8; ++d0) S.qr[d0] = pack8(S.tq[2 * d0], S.tq[2 * d0 + 1]); }
    __syncthreads();
#undef RESC
#undef KBASE
#undef BIASP
#undef ACT
#undef MASKT
#undef SEAM_K0
#undef HALF_STEP
}
#undef ROWK
#undef ROWV
#undef VMW
#undef VMWN
#undef SLOAD_H
#undef SWRITE_HK
#undef SWRITE_HV
#undef SWRITE_H
#undef SLOAD_F
#undef SWRITE_KF
#undef SWRITE_VF

}

constexpr int NWAVES = 8;
constexpr int S_ = 8192, DM = 2048, NEXP = 32, TOPK = 4, DFF = 2048;
constexpr int INW = 11288;
constexpr int NZT = 11520;
constexpr int NPH = 14;
constexpr int N_LAUNCHES = MK_N_LAUNCHES;
constexpr float EPS_ = 1e-6f;
constexpr int GW3 = 128;
constexpr int MPAD = 40960;

constexpr size_t MiB = 1u << 20;
constexpr size_t WS_CTL = 0, CTL_ZERO_BYTES = 1 * MiB;
constexpr size_t WS_MODP = 1 * MiB, WS_MOD = 4 * MiB, WS_WRT = 5 * MiB, WS_G24 = 6 * MiB, WS_EIDX = 7 * MiB, WS_ESLOT = 8 * MiB, WS_EW = 9 * MiB, WS_SW = 10 * MiB;
constexpr size_t WS_SC = 11 * MiB;
constexpr size_t WS_BL = 12 * MiB, WS_IPL = 13 * MiB, WS_FLOC = 14 * MiB, WS_UN = 15 * MiB, WS_NST = 16 * MiB;
constexpr size_t WS_WMT = 17 * MiB, WS_WFT = 21 * MiB, WS_WOUTT = 25 * MiB, WS_WINT = 33 * MiB;
constexpr size_t WS_XN = 78 * MiB, WS_QF = 110 * MiB, WS_KF = 126 * MiB, WS_OB = 142 * MiB, WS_HMF = 158 * MiB  , WS_QM = 190 * MiB, WS_KM = 206 * MiB;
constexpr size_t WS_U = 222 * MiB, WS_CST = 254 * MiB, WS_T1 = 286 * MiB, WS_Y = 350 * MiB, WS_Z = 382 * MiB, WS_XG = 558 * MiB, WS_ACT = 718 * MiB, WS_YS = 878 * MiB;
constexpr size_t WS_WGUT = 1038 * MiB, WS_WDT = 1550 * MiB;
constexpr size_t WS_PO = 1806 * MiB, WS_PML = 2318 * MiB, WS_NPART = 2326 * MiB;
constexpr size_t WS_XN8 = 558 * MiB  , WS_WINT8 = 286 * MiB  ;
constexpr size_t WS_XGE = 2327 * MiB, WS_SWE = 2860 * MiB, WS_Z8 = 2861 * MiB, WS_END = 2909 * MiB;
static_assert(WS_WINT + (size_t)NZT * DM * 2 <= WS_XN && WS_Z + (size_t)S_ * 11264 * 2 <= WS_XG && WS_XG + (size_t)MPAD * DM * 2 <= WS_ACT, "ws map");
constexpr int CW_BAR = 4096;
constexpr int CW_CNT = 16384;
constexpr int CW_Q = 32768;

constexpr int RING_OFF = 0, RING_BYTES = 131072;
constexpr int LDSCTL_OFF = RING_BYTES, MISC_OFF = LDSCTL_OFF;
constexpr int TILE_E_OFF = LDSCTL_OFF + 256;
constexpr int EOFF_OFF = LDSCTL_OFF + 1024;
constexpr int LDS_BYTES = 147456;

#define GAS __attribute__((address_space(1)))
#define LAS __attribute__((address_space(3)))
typedef unsigned short bf16;
typedef unsigned v4u __attribute__((ext_vector_type(4)));
typedef unsigned v2u __attribute__((ext_vector_type(2)));
typedef float f32x4 __attribute__((ext_vector_type(4)));
typedef float f32x2_t __attribute__((ext_vector_type(2)));
typedef GAS unsigned gu32;
__device__ __forceinline__ unsigned f2bf(float f) { unsigned u = __builtin_bit_cast(unsigned, f); return (u + 0x7fffu + ((u >> 16) & 1u)) >> 16; }
typedef __bf16 bf16x2_hw __attribute__((ext_vector_type(2)));
__device__ __forceinline__ unsigned pk2(float lo, float hi) { const f32x2_t v = {lo, hi}; return __builtin_bit_cast(unsigned, __builtin_convertvector(v, bf16x2_hw)); }
__device__ __forceinline__ float bflo(unsigned w) { return __builtin_bit_cast(float, w << 16); }
__device__ __forceinline__ float bfhi(unsigned w) { return __builtin_bit_cast(float, w & 0xffff0000u); }
__device__ __forceinline__ float sigm(float x) { return __builtin_amdgcn_rcpf(1.f + __builtin_amdgcn_exp2f(-1.4426950408889634f * x)); }
__device__ __forceinline__ float logsig(float x) { const float e = __builtin_amdgcn_exp2f(-1.4426950408889634f * fabsf(x)); const float l = 0.6931471805599453f * __builtin_amdgcn_logf(1.f + e); return (x < 0.f ? x : 0.f) - l; }
__device__ __forceinline__ float wave_sum(float v) {
#pragma unroll
    for (int o = 1; o < 64; o <<= 1) v += __shfl_xor(v, o);
    return v;
}
__device__ __forceinline__ float wave_max(float v) {
#pragma unroll
    for (int o = 1; o < 64; o <<= 1) v = fmaxf(v, __shfl_xor(v, o));
    return v;
}
__device__ __forceinline__ float wave_scan_add(float v, int lane) {
#pragma unroll
    for (int o = 1; o < 64; o <<= 1) { const float t = __shfl_up(v, o); if (lane >= o) v += t; }
    return v;
}
__device__ __forceinline__ float wave_scan_max(float v, int lane) {
#pragma unroll
    for (int o = 1; o < 64; o <<= 1) { const float t = __shfl_up(v, o); if (lane >= o) v = fmaxf(v, t); }
    return v;
}

#define XB_TMO      128
#define XB_XCNT(j)  (256  + 64 * (j))
#define XB_XSUB(j)  (1280 + 64 * (j))
#define XB_XGEN(j)  (2304 + 64 * (j))
#define XB_TOP      3328
#define XB_TOPGEN   3392
#define XCD_BAR_WORDS 3456
#define XB_SPIN_CAP (1u << 18)

__device__ __forceinline__ unsigned xb_ld(unsigned* p)              { return __hip_atomic_load(p, __ATOMIC_RELAXED, __HIP_MEMORY_SCOPE_AGENT); }
__device__ __forceinline__ unsigned xb_add(unsigned* p, unsigned v) { return __hip_atomic_fetch_add(p, v, __ATOMIC_RELAXED, __HIP_MEMORY_SCOPE_AGENT); }
__device__ __forceinline__ unsigned xb_xcc_id() { return (unsigned)__builtin_amdgcn_s_getreg((3 << 11) | 20) & 0xFu; }
#define XB_SPIN(cond, bar) do { unsigned _sp = 0; while (cond) { __builtin_amdgcn_s_sleep(1); \
    if ((++_sp & 255u) == 0u) { if (xb_ld(&(bar)[XB_TMO])) break; if (_sp > XB_SPIN_CAP) { atomicAdd(&(bar)[XB_TMO], 1u); break; } } } } while (0)

struct XcdBarrier {
    unsigned* bar; unsigned x;
    volatile LAS unsigned* st;
};

__device__ __forceinline__ XcdBarrier xcd_barrier_post(unsigned* bar, volatile LAS unsigned* st) {
    XcdBarrier b; b.bar = bar; b.x = xb_xcc_id(); b.st = st;
    if (threadIdx.x == 0) (void)xb_add(&bar[XB_XCNT(b.x)], 1u);
    return b;
}
__device__ __forceinline__ void xcd_barrier_complete(unsigned* bar, unsigned x, unsigned& nloc, unsigned& nx) {
    const unsigned G = gridDim.x * gridDim.y * gridDim.z;
    unsigned sum, cnt, mine, sp = 0u;
    for (;;) {
        sum = 0u; cnt = 0u; mine = 0u;
#pragma unroll
        for (unsigned j = 0; j < 16; ++j) { const unsigned c = xb_ld(&bar[XB_XCNT(j)]); sum += c; cnt += (c > 0u) ? 1u : 0u; mine = (j == x) ? c : mine; }
        if (sum == G) break;
        __builtin_amdgcn_s_sleep(1);
        if ((++sp & 255u) == 0u) { if (xb_ld(&bar[XB_TMO])) break; if (sp > XB_SPIN_CAP) { atomicAdd(&bar[XB_TMO], 1u); break; } }
    }
    nloc = mine > 0u ? mine : 1u; nx = cnt > 0u ? cnt : 1u;
}

__device__ __forceinline__ void xcd_barrier(const XcdBarrier& b) {
    asm volatile("s_waitcnt vmcnt(0)" ::: "memory");
    __syncthreads();
    if (threadIdx.x == 0) {
        unsigned* bar = b.bar;
        __builtin_amdgcn_s_waitcnt(0);
        unsigned nloc = b.st[0], nx = b.st[1];
        if (nloc == 0u) { xcd_barrier_complete(bar, b.x, nloc, nx); b.st[0] = nloc; b.st[1] = nx; }
        const unsigned old = xb_add(&bar[XB_XSUB(b.x)], 1u);
        const unsigned gen = old / nloc;
        if (old + 1u == (gen + 1u) * nloc) {
            __builtin_amdgcn_fence(__ATOMIC_RELEASE, "agent");
            asm volatile("s_waitcnt vmcnt(0)" ::: "memory");
            const unsigned og = xb_add(&bar[XB_TOP], 1u);
            const unsigned tg = og / nx;
            if (og + 1u == (tg + 1u) * nx) xb_add(&bar[XB_TOPGEN], 1u);
            else XB_SPIN(xb_ld(&bar[XB_TOPGEN]) == tg, bar);
            __builtin_amdgcn_fence(__ATOMIC_ACQUIRE, "agent");
            xb_add(&bar[XB_XGEN(b.x)], 1u);
            asm volatile("s_waitcnt vmcnt(0)" ::: "memory");
        } else {
            XB_SPIN(xb_ld(&bar[XB_XGEN(b.x)]) == gen, bar);
            __builtin_amdgcn_fence(__ATOMIC_ACQUIRE, "agent");
            asm volatile("s_waitcnt vmcnt(0)" ::: "memory");
        }
    }
    __syncthreads();
}

struct Frame { LAS unsigned char* lds; int tid, lane, wave, vcu, G; };

struct Args { const float* in[25]; float* out; unsigned char* ws; int ph_lo, ph_hi; };
static_assert(sizeof(Args) == 25 * 8 + 8 + 8 + 8, "Args has no padding");

enum { I_X = 0, I_C, I_ADAW, I_ADAB, I_N1G, I_WIN, I_CONVW, I_CONVB, I_MIB, I_MFB, I_MONG, I_FFB, I_FQG, I_FKG, I_WBM, I_WBF, I_WOUT, I_N2G, I_WR, I_BR, I_WGU, I_BGU, I_WD, I_BD, I_FNG };

__device__ __forceinline__ void tr_item(const float* __restrict__ W, int N, int K, int k0, int src_n0, bf16* __restrict__ WT, int dst_row0, int lane, int dk = 0) {
    const int kq = lane >> 4, nq = lane & 15;
    const float* src = W + (size_t)(k0 + 16 * kq) * N + src_n0 + 4 * nq;
    f32x4 v[16];
#pragma unroll
    for (int j = 0; j < 16; ++j) v[j] = *(const f32x4*)(src + (size_t)j * N);
#pragma unroll
    for (int i = 0; i < 4; ++i) {
        v4u lo, hi;
        lo.x = pk2(v[0][i], v[1][i]); lo.y = pk2(v[2][i], v[3][i]); lo.z = pk2(v[4][i], v[5][i]); lo.w = pk2(v[6][i], v[7][i]);
        hi.x = pk2(v[8][i], v[9][i]); hi.y = pk2(v[10][i], v[11][i]); hi.z = pk2(v[12][i], v[13][i]); hi.w = pk2(v[14][i], v[15][i]);
        bf16* d = WT + (size_t)(dst_row0 + 4 * nq + i) * K + dk + k0 + 16 * kq;
        *(v4u*)d = lo; *(v4u*)(d + 8) = hi;
    }
}

__device__ __forceinline__ void tr_item8(const float* __restrict__ W, int N, int K, int k0, int src_n0, unsigned char* __restrict__ WT, int dst_row0, int lane) {
    const int kq = lane >> 4, nq = lane & 15;
    const float* src = W + (size_t)(k0 + 32 * kq) * N + src_n0 + 4 * nq;
    f32x4 v[32];
#pragma unroll
    for (int j = 0; j < 32; ++j) v[j] = __builtin_nontemporal_load((const f32x4*)(src + (size_t)j * N));
#pragma unroll
    for (int i = 0; i < 4; ++i) {
        v4u o0, o1;
        o0.x = pg8::pack_fp8x4(v[0][i] * 64.f, v[1][i] * 64.f, v[2][i] * 64.f, v[3][i] * 64.f); o0.y = pg8::pack_fp8x4(v[4][i] * 64.f, v[5][i] * 64.f, v[6][i] * 64.f, v[7][i] * 64.f);
        o0.z = pg8::pack_fp8x4(v[8][i] * 64.f, v[9][i] * 64.f, v[10][i] * 64.f, v[11][i] * 64.f); o0.w = pg8::pack_fp8x4(v[12][i] * 64.f, v[13][i] * 64.f, v[14][i] * 64.f, v[15][i] * 64.f);
        o1.x = pg8::pack_fp8x4(v[16][i] * 64.f, v[17][i] * 64.f, v[18][i] * 64.f, v[19][i] * 64.f); o1.y = pg8::pack_fp8x4(v[20][i] * 64.f, v[21][i] * 64.f, v[22][i] * 64.f, v[23][i] * 64.f);
        o1.z = pg8::pack_fp8x4(v[24][i] * 64.f, v[25][i] * 64.f, v[26][i] * 64.f, v[27][i] * 64.f); o1.w = pg8::pack_fp8x4(v[28][i] * 64.f, v[29][i] * 64.f, v[30][i] * 64.f, v[31][i] * 64.f);
        unsigned char* d = WT + (size_t)(dst_row0 + 4 * nq + i) * K + k0 + 32 * kq;
        __builtin_nontemporal_store(o0, (v4u*)d); __builtin_nontemporal_store(o1, (v4u*)(d + 16));
    }
}

__device__ __forceinline__ void ph0_prologue(const Frame& F, const Args& A) {
    unsigned char* ws = A.ws;
    const int gw = F.vcu * NWAVES + F.wave, NGW = F.G * NWAVES;
    {
        const float* c = A.in[I_C]; const float* aw = A.in[I_ADAW]; float* MODP = (float*)(ws + WS_MODP);
        for (int it = F.vcu; it < 64 * 6; it += F.G) {
            const int slab = it / 6, cb = it % 6, col = cb * 2048 + F.tid * 4;
            f32x4 acc = {0.f, 0.f, 0.f, 0.f};
#pragma unroll 8
            for (int k = slab * 32; k < slab * 32 + 32; ++k) { const float cv = c[k]; const float s = cv / (1.f + expf(-cv));
                const f32x4 w = *(const f32x4*)(aw + (size_t)k * 12288 + col); acc += w * s; }
            *(f32x4*)(MODP + (size_t)slab * 12288 + col) = acc;
        }
    }
    {
        const float* win = A.in[I_WIN]; bf16* WinT = (bf16*)(ws + WS_WINT); const float* wr = A.in[I_WR]; float* WRT = (float*)(ws + WS_WRT);
        const int gt = F.vcu * 512 + F.tid, NGT = F.G * 512;
        for (int idx = gt; idx < 24 * 2048; idx += NGT) { const int j = idx >> 11, k = idx & 2047; const int sc = j < 16 ? 2048 + j : 6160 + (j - 16);
            WinT[(size_t)(11264 + j) * 2048 + k] = (bf16)f2bf(win[(size_t)k * INW + sc]); }
        for (int idx = gt; idx < 32 * 2048; idx += NGT) { const int e = idx >> 11, k = idx & 2047; WRT[idx] = wr[(size_t)k * 32 + e]; }
    }
    {
        constexpr int I_IN = 32 * 80, I_IN8 = 16 * 96, I_M = 16 * 32, I_F = 16 * 32, I_O = 32 * 32;
        constexpr int NIT = I_IN + I_IN8 + I_M + I_F + I_O;
        for (int it = gw; it < NIT; it += NGW) {
            int r = it;
            if (r < I_IN) { const int kb = r / 80, nb = r % 80, dn = (nb < 32 ? nb : nb + 16) * 64; const int sn = dn < 2048 ? dn : dn + 16;
                tr_item(A.in[I_WIN], INW, 2048, kb * 64, sn, (bf16*)(ws + WS_WINT), dn, F.lane); continue; } r -= I_IN;
            if (r < I_IN8) { const int kb = r / 96, nb = r % 96, dn = (nb < 16 ? 32 + nb : 80 + nb) * 64; const int sn = dn < 6144 ? dn + 16 : dn + 24;
                tr_item8(A.in[I_WIN], INW, 2048, kb * 128, sn, (unsigned char*)(ws + WS_WINT8), dn, F.lane); continue; } r -= I_IN8;
            if (r < I_M) { const int kb = r / 32, nb = r % 32; tr_item(A.in[I_WBM], 2048, 2048, kb * 64, nb * 64, (bf16*)(ws + WS_WMT), nb * 64, F.lane, 0); continue; } r -= I_M;
            if (r < I_F) { const int kb = r / 32, nb = r % 32; tr_item(A.in[I_WBF], 2048, 2048, kb * 64, nb * 64, (bf16*)(ws + WS_WMT), nb * 64, F.lane, 1024); continue; } r -= I_F;
            { const int kb = r / 32, nb = r % 32; tr_item(A.in[I_WOUT], 2048, 2048, kb * 64, nb * 64, (bf16*)(ws + WS_WOUTT), nb * 64, F.lane); }
        }
    }
}

constexpr int MQ_GU = 32 * 1024, MQ_DN = 32 * 512, MQ_N = MQ_GU + MQ_DN, MQ_GRAB = 16;
__device__ __forceinline__ void mq_half_dma(const float* W, int N, int k0, int n0, LAS unsigned char* slice, int lane) {
    const float* src = W + (size_t)(k0 + (lane >> 4)) * N + n0 + 4 * (lane & 15);
#pragma unroll
    for (int j = 0; j < 16; ++j) __builtin_amdgcn_global_load_lds((const unsigned*)(src + (size_t)(4 * j) * N), (LAS unsigned*)(slice + j * 1024), 16, 0, 2);
}
__device__ __forceinline__ void mq_half_cvt(unsigned char* WT, int dst_row0, int k0, const LAS unsigned char* slice, int lane) {
    const int kq = lane >> 4, nq = lane & 15;
    f32x4 v[16];
#pragma unroll
    for (int i = 0; i < 16; ++i) v[i] = *(const LAS f32x4*)(slice + (16 * kq + i) * 256 + nq * 16);
#pragma unroll
    for (int i = 0; i < 4; ++i) { v4u o;
        o.x = pg8::pack_fp8x4(v[0][i] * 64.f, v[1][i] * 64.f, v[2][i] * 64.f, v[3][i] * 64.f); o.y = pg8::pack_fp8x4(v[4][i] * 64.f, v[5][i] * 64.f, v[6][i] * 64.f, v[7][i] * 64.f);
        o.z = pg8::pack_fp8x4(v[8][i] * 64.f, v[9][i] * 64.f, v[10][i] * 64.f, v[11][i] * 64.f); o.w = pg8::pack_fp8x4(v[12][i] * 64.f, v[13][i] * 64.f, v[14][i] * 64.f, v[15][i] * 64.f);
        __builtin_nontemporal_store(o, (v4u*)(WT + (size_t)(dst_row0 + 4 * nq + i) * 2048 + k0 + 16 * kq)); }
}
__device__ __forceinline__ void moe_convert_queue(const Frame& F, const Args& A) {
    unsigned char* ws = A.ws;
    unsigned* Q = (unsigned*)(ws + WS_CTL) + CW_Q;
    LAS int* qb = (LAS int*)(F.lds + LDSCTL_OFF + 1536);
    LAS unsigned char* slice = F.lds + RING_OFF + F.wave * 16384;
    for (;;) {
        __syncthreads();
        if (F.tid == 0) *qb = (int)__hip_atomic_fetch_add(Q, (unsigned)MQ_GRAB, __ATOMIC_RELAXED, __HIP_MEMORY_SCOPE_AGENT);
        __syncthreads();
        const int base = __builtin_amdgcn_readfirstlane(*qb);
        if (base >= MQ_N) break;
#pragma unroll 1
        for (int k = 0; k < 2 * (MQ_GRAB / NWAVES); ++k) { const int r = base + F.wave * (MQ_GRAB / NWAVES) + (k >> 1), kh = k & 1;
            const float* W; unsigned char* WT; int N, k0, n0, drow;
            if (r < MQ_GU) { const int e = r / 1024, rr = r % 1024, kb = rr / 64, nb = rr % 64; const int pn = nb >> 2, q = nb & 3;
                W = A.in[I_WGU] + (size_t)e * 2048 * 4096; N = 4096; k0 = kb * 128 + 64 * kh; n0 = (q >> 1) * 2048 + 128 * pn + (q & 1) * 64; WT = (unsigned char*)(ws + WS_WGUT) + (size_t)e * 4096 * 2048; drow = nb * 64; }
            else { const int r2 = r - MQ_GU, e = r2 / 512, rr = r2 % 512, kb = rr / 32, nb = rr % 32;
                W = A.in[I_WD] + (size_t)e * 2048 * 2048; N = 2048; k0 = kb * 128 + 64 * kh; n0 = nb * 64; WT = (unsigned char*)(ws + WS_WDT) + (size_t)e * 2048 * 2048; drow = nb * 64; }
            asm volatile("s_waitcnt lgkmcnt(0)" ::: "memory");
            mq_half_dma(W, N, k0, n0, slice, F.lane);
            asm volatile("s_waitcnt vmcnt(0)" ::: "memory");
            mq_half_cvt(WT, drow, k0, slice, F.lane);
        }
    }
}

__device__ __forceinline__ void ph1_modreduce(const Frame& F, const Args& A) {
    const float* MODP = (const float*)(A.ws + WS_MODP); float* MOD = (float*)(A.ws + WS_MOD); const float* ab = A.in[I_ADAB];
    for (int j = F.vcu * 512 + F.tid; j < 12288; j += F.G * 512) { float s = ab[j];
#pragma unroll 8
        for (int sl = 0; sl < 64; ++sl) s += MODP[(size_t)sl * 12288 + j];
        MOD[j] = s; }
}

__device__ __forceinline__ void ph2_norm1(const Frame& F, const Args& A) {
    const float* x = A.in[I_X]; const float* g1 = A.in[I_N1G]; const float* MOD = (const float*)(A.ws + WS_MOD); bf16* XN = (bf16*)(A.ws + WS_XN);
    const int gw = F.vcu * NWAVES + F.wave, NGW = F.G * NWAVES;
    for (int row = gw; row < S_; row += 2 * NGW) {
        const int rowb = row + NGW < S_ ? row + NGW : row;
        const f32x4* xa = (const f32x4*)(x + (size_t)row * DM) + F.lane; const f32x4* xb = (const f32x4*)(x + (size_t)rowb * DM) + F.lane;
        f32x4 va[8], vb[8]; float sa = 0.f, sb = 0.f;
#pragma unroll
        for (int j = 0; j < 8; ++j) { va[j] = xa[64 * j]; vb[j] = xb[64 * j]; }
#pragma unroll
        for (int j = 0; j < 8; ++j) { sa += (va[j].x * va[j].x + va[j].y * va[j].y) + (va[j].z * va[j].z + va[j].w * va[j].w); sb += (vb[j].x * vb[j].x + vb[j].y * vb[j].y) + (vb[j].z * vb[j].z + vb[j].w * vb[j].w); }
        const float ra = 1.f / sqrtf(wave_sum(sa) * (1.f / DM) + EPS_), rb = 1.f / sqrtf(wave_sum(sb) * (1.f / DM) + EPS_);
        unsigned long long* oa = (unsigned long long*)(XN + (size_t)row * DM) + F.lane; unsigned long long* ob = (unsigned long long*)(XN + (size_t)rowb * DM) + F.lane;
#pragma unroll
        for (int j = 0; j < 8; ++j) { const int col = 4 * F.lane + 256 * j;
            const f32x4 g = *(const f32x4*)(g1 + col), sh = *(const f32x4*)(MOD + col), sc = *(const f32x4*)(MOD + 2048 + col);
            const f32x4 ha = va[j] * ra * g * (sc + 1.f) + sh, hb = vb[j] * rb * g * (sc + 1.f) + sh;
            oa[64 * j] = (unsigned long long)pk2(ha.x, ha.y) | ((unsigned long long)pk2(ha.z, ha.w) << 32);
            ob[64 * j] = (unsigned long long)pk2(hb.x, hb.y) | ((unsigned long long)pk2(hb.z, hb.w) << 32);
            ((unsigned*)((unsigned char*)(A.ws + WS_XN8) + (size_t)row * DM) + F.lane)[64 * j] = pg8::pack_fp8x4(ha.x, ha.y, ha.z, ha.w);
            ((unsigned*)((unsigned char*)(A.ws + WS_XN8) + (size_t)rowb * DM) + F.lane)[64 * j] = pg8::pack_fp8x4(hb.x, hb.y, hb.z, hb.w); }
    }
}

#define TRRD_(dst, base, off) asm volatile("ds_read_b64_tr_b16 %0, %1 offset:%2" : "=&v"(dst) : "v"(base), "i"(off) : "memory")
#define TR8_(lo, hi) (fox::bf16x8){lo[0], lo[1], lo[2], lo[3], hi[0], hi[1], hi[2], hi[3]}
#define LDSW_() do { asm volatile("s_waitcnt lgkmcnt(0)" ::: "memory"); __builtin_amdgcn_sched_barrier(0); } while (0)
template <int DA, int DB> __device__ __forceinline__ void mm_tr_tr(fox::f32x16& acc, int ta, int tb) {
    fox::s16x4 a0, a1, a2, a3, a4, a5, a6, a7, b0, b1, b2, b3, b4, b5, b6, b7;
    TRRD_(a0, ta, DA * 512); TRRD_(a1, ta, DA * 512 + 2048); TRRD_(a2, ta, DA * 512 + 4096); TRRD_(a3, ta, DA * 512 + 6144);
    TRRD_(a4, ta, DA * 512 + 8192); TRRD_(a5, ta, DA * 512 + 10240); TRRD_(a6, ta, DA * 512 + 12288); TRRD_(a7, ta, DA * 512 + 14336);
    TRRD_(b0, tb, DB * 512); TRRD_(b1, tb, DB * 512 + 2048); TRRD_(b2, tb, DB * 512 + 4096); TRRD_(b3, tb, DB * 512 + 6144);
    TRRD_(b4, tb, DB * 512 + 8192); TRRD_(b5, tb, DB * 512 + 10240); TRRD_(b6, tb, DB * 512 + 12288); TRRD_(b7, tb, DB * 512 + 14336);
    LDSW_();
    acc = __builtin_amdgcn_mfma_f32_32x32x16_bf16(TR8_(a0, a1), TR8_(b0, b1), acc, 0, 0, 0);
    acc = __builtin_amdgcn_mfma_f32_32x32x16_bf16(TR8_(a2, a3), TR8_(b2, b3), acc, 0, 0, 0);
    acc = __builtin_amdgcn_mfma_f32_32x32x16_bf16(TR8_(a4, a5), TR8_(b4, b5), acc, 0, 0, 0);
    acc = __builtin_amdgcn_mfma_f32_32x32x16_bf16(TR8_(a6, a7), TR8_(b6, b7), acc, 0, 0, 0);
}
template <int DA> __device__ __forceinline__ void mm_tr_row(fox::f32x16& acc, int ta, const LAS bf16* brow) {
    fox::s16x4 a0, a1, a2, a3, a4, a5, a6, a7;
    TRRD_(a0, ta, DA * 512); TRRD_(a1, ta, DA * 512 + 2048); TRRD_(a2, ta, DA * 512 + 4096); TRRD_(a3, ta, DA * 512 + 6144);
    TRRD_(a4, ta, DA * 512 + 8192); TRRD_(a5, ta, DA * 512 + 10240); TRRD_(a6, ta, DA * 512 + 12288); TRRD_(a7, ta, DA * 512 + 14336);
    const fox::bf16x8 b0 = *(const LAS fox::bf16x8*)(brow), b1 = *(const LAS fox::bf16x8*)(brow + 16), b2 = *(const LAS fox::bf16x8*)(brow + 32), b3 = *(const LAS fox::bf16x8*)(brow + 48);
    LDSW_();
    acc = __builtin_amdgcn_mfma_f32_32x32x16_bf16(TR8_(a0, a1), b0, acc, 0, 0, 0);
    acc = __builtin_amdgcn_mfma_f32_32x32x16_bf16(TR8_(a2, a3), b1, acc, 0, 0, 0);
    acc = __builtin_amdgcn_mfma_f32_32x32x16_bf16(TR8_(a4, a5), b2, acc, 0, 0, 0);
    acc = __builtin_amdgcn_mfma_f32_32x32x16_bf16(TR8_(a6, a7), b3, acc, 0, 0, 0);
}
__device__ __forceinline__ void mm_row_row(fox::f32x16& acc, const LAS bf16* arow, const LAS bf16* brow) {
#pragma unroll
    for (int ks = 0; ks < 4; ++ks) acc = __builtin_amdgcn_mfma_f32_32x32x16_bf16(*(const LAS fox::bf16x8*)(arow + 16 * ks), *(const LAS fox::bf16x8*)(brow + 16 * ks), acc, 0, 0, 0);
}
constexpr int LP = 72;

__device__ __forceinline__ void ph4_unit(const Frame& F, const Args& A, int c, int h) {
    unsigned char* ws = A.ws;
    const bf16* Z = (const bf16*)(ws + WS_Z); const float* G24 = (const float*)(ws + WS_G24);
    LAS unsigned char* Vt = F.lds + RING_OFF;
    LAS unsigned char* Kw = Vt + 16384;
    LAS float* wkL = (LAS float*)(Kw + 16384);
    LAS float* uL = wkL + 64;
    const int t0 = c * 64, tid = F.tid, lane = F.lane;
    const int ch = tid & 127, tq = tid >> 7, isk = ch >> 6, d = ch & 63, zc = isk * 512 + h * 64 + d, tb = t0 + 16 * tq;
    float zin[19];
#pragma unroll
    for (int i = 0; i < 19; ++i) { const int tt = tb - 3 + i; zin[i] = tt >= 0 ? pg8::bf2f(Z[(size_t)tt * pg8::ZLD + zc]) : 0.f; }
    v4u vv[2];
#pragma unroll
    for (int i = 0; i < 2; ++i) { const int idx = tid + 512 * i, sx = idx >> 4, c8 = (idx & 15) * 8; vv[i] = *(const v4u*)(Z + (size_t)(t0 + sx) * pg8::ZLD + 1024 + h * 128 + c8); }
    unsigned qw[16];
#pragma unroll
    for (int i = 0; i < 16; ++i) { const int rv = F.wave * 16 + i, t = rv >> 1, isk2 = rv & 1, zc0 = 3072 + isk2 * 1024 + h * 128;
        qw[i] = *(const unsigned*)(Z + (size_t)(t0 + t) * pg8::ZLD + zc0 + 2 * lane); }
    const float* cw = A.in[I_CONVW]; const float w0 = cw[zc], w1 = cw[1024 + zc], w2 = cw[2048 + zc], w3 = cw[3072 + zc], bb = A.in[I_CONVB][zc];
    if (F.wave == 0) {
        const float* gr = G24 + (size_t)(t0 + lane) * 24;
        const float ip = gr[h] + A.in[I_MIB][h], lf = logsig(gr[8 + h] + A.in[I_MFB][h]), lff = logsig(gr[16 + h] + A.in[I_FFB][h]);
        const float b = wave_scan_add(lf, lane), fl = wave_scan_add(lff, lane), g = __shfl(b, 63);
        const float a = g - b + ip, amax = wave_max(a), wk = expf(a - amax);
        ((float*)(ws + WS_BL))[h * S_ + t0 + lane] = b; ((float*)(ws + WS_IPL))[h * S_ + t0 + lane] = ip; ((float*)(ws + WS_FLOC))[h * S_ + t0 + lane] = fl;
        wkL[lane] = wk; uL[lane] = 0.f;
        if (lane == 63) { float* SC = (float*)(ws + WS_SC); SC[h * 128 + c] = b; SC[1024 + h * 128 + c] = amax; SC[2048 + h * 128 + c] = fl; }
    }
#pragma unroll
    for (int i = 0; i < 2; ++i) { const int idx = tid + 512 * i, sx = idx >> 4, c8 = (idx & 15) * 8; *(LAS v4u*)(Vt + fox::v_st(sx, c8)) = vv[i]; }
    __syncthreads();
    {
        bf16* QMb = (bf16*)(ws + WS_QM); bf16* KMb = (bf16*)(ws + WS_KM);
        float usum = 0.f;
#pragma unroll
        for (int i = 0; i < 16; ++i) { const float y = bb + w0 * zin[i] + w1 * zin[i + 1] + w2 * zin[i + 2] + w3 * zin[i + 3];
            float sv = y * __builtin_amdgcn_rcpf(1.f + __builtin_amdgcn_exp2f(-1.4426950408889634f * y));
            if (isk) { sv *= 0.125f; const float kw = sv * wkL[16 * tq + i]; usum += kw;
                KMb[((size_t)h * S_ + tb + i) * 64 + d] = (bf16)f2bf(sv); *(LAS bf16*)(Kw + fox::v_st(16 * tq + i, d)) = (bf16)f2bf(kw); }
            else QMb[((size_t)h * S_ + tb + i) * 64 + d] = (bf16)f2bf(sv); }
        if (isk) __hip_atomic_fetch_add(uL + d, usum, __ATOMIC_RELAXED, __HIP_MEMORY_SCOPE_WORKGROUP);
    }
    __syncthreads();
    {
        const int eb = F.wave >> 1, db = F.wave & 1, r32 = lane & 31, hi = lane >> 5;
        const int ta = (int)(uintptr_t)Vt + fox::v_rd_base(lane), tbb = (int)(uintptr_t)Kw + fox::v_rd_base(lane);
        fox::f32x16 acc = {};
        if (eb == 0) { if (db == 0) mm_tr_tr<0, 0>(acc, ta, tbb); else mm_tr_tr<0, 1>(acc, ta, tbb); }
        else if (eb == 1) { if (db == 0) mm_tr_tr<1, 0>(acc, ta, tbb); else mm_tr_tr<1, 1>(acc, ta, tbb); }
        else if (eb == 2) { if (db == 0) mm_tr_tr<2, 0>(acc, ta, tbb); else mm_tr_tr<2, 1>(acc, ta, tbb); }
        else { if (db == 0) mm_tr_tr<3, 0>(acc, ta, tbb); else mm_tr_tr<3, 1>(acc, ta, tbb); }
        bf16* Up = (bf16*)(ws + WS_U) + ((size_t)h * 128 + c) * 8192 + 32 * db + r32;
#pragma unroll
        for (int i = 0; i < 16; ++i) Up[(size_t)(32 * eb + fox::crow(i, hi)) * 64] = (bf16)f2bf(acc[i]);
        if (tid < 64) ((float*)(ws + WS_UN))[((size_t)h * 128 + c) * 64 + tid] = uL[tid];
    }
    {
        bf16* QF = (bf16*)(ws + WS_QF); bf16* KF = (bf16*)(ws + WS_KF);
        const float gq0 = A.in[I_FQG][h * 128 + 2 * lane], gq1 = A.in[I_FQG][h * 128 + 2 * lane + 1], gk0 = A.in[I_FKG][h * 128 + 2 * lane], gk1 = A.in[I_FKG][h * 128 + 2 * lane + 1];
        float rl;
        { float s0[16], s1[8], s2[4], s3[2];
          const bool b0 = lane & 1, b1 = lane & 2, b2 = lane & 4, b3 = lane & 8;
#pragma unroll
          for (int i = 0; i < 16; ++i) { const float x0 = bflo(qw[i]), x1 = bfhi(qw[i]); s0[i] = x0 * x0 + x1 * x1; }
#pragma unroll
          for (int k = 0; k < 8; ++k) s1[k] = (b0 ? s0[2 * k + 1] : s0[2 * k]) + __shfl_xor(b0 ? s0[2 * k] : s0[2 * k + 1], 1);
#pragma unroll
          for (int k = 0; k < 4; ++k) s2[k] = (b1 ? s1[2 * k + 1] : s1[2 * k]) + __shfl_xor(b1 ? s1[2 * k] : s1[2 * k + 1], 2);
#pragma unroll
          for (int k = 0; k < 2; ++k) s3[k] = (b2 ? s2[2 * k + 1] : s2[2 * k]) + __shfl_xor(b2 ? s2[2 * k] : s2[2 * k + 1], 4);
          float s4 = (b3 ? s3[1] : s3[0]) + __shfl_xor(b3 ? s3[0] : s3[1], 8);
          s4 += __shfl_xor(s4, 16); s4 += __shfl_xor(s4, 32);
          rl = __builtin_amdgcn_rsqf(s4 * (1.f / 128.f) + EPS_); }
#pragma unroll
        for (int i = 0; i < 16; ++i) { const int rv = F.wave * 16 + i, t = rv >> 1, isk2 = rv & 1; const float x0 = bflo(qw[i]), x1 = bfhi(qw[i]);
            const float r = __builtin_bit_cast(float, __builtin_amdgcn_readlane(__builtin_bit_cast(int, rl), i));
            *(unsigned*)((isk2 ? KF : QF) + (size_t)(t0 + t) * 1024 + h * 128 + 2 * lane) = pk2(x0 * r * (isk2 ? gk0 : gq0), x1 * r * (isk2 ? gk1 : gq1)); }
    }
    __syncthreads();
}

constexpr int T_INCL = 103424;
constexpr int T_COST = 107520;
constexpr int T_PREF = 108544;
constexpr int T_JLO  = 109600;
constexpr int T_TH   = 110624;
constexpr int T_DEC  = 111616;
constexpr int T_SCL  = 115712;
constexpr int T_OWN  = 119808;
constexpr int MAXP = 16;

__device__ __forceinline__ int fox_owner(int x, int total, int ge) { return (int)((((long)x + 1) * ge - 1) / total); }

__device__ __forceinline__ void ph5_tables(const Frame& F, const Args& A) {
    unsigned char* ws = A.ws; const float* SC = (const float*)(ws + WS_SC);
    LAS float* inclL = (LAS float*)(F.lds + T_INCL); LAS int* costL = (LAS int*)(F.lds + T_COST); LAS int* prefL = (LAS int*)(F.lds + T_PREF); LAS int* jloL = (LAS int*)(F.lds + T_JLO);
    LAS float* thL = (LAS float*)(F.lds + T_TH); LAS float* decL = (LAS float*)(F.lds + T_DEC); LAS float* sclL = (LAS float*)(F.lds + T_SCL);
    const int h = F.wave, l = F.lane;
    {
        const float v0 = SC[2048 + h * 128 + 2 * l], v1 = SC[2048 + h * 128 + 2 * l + 1]; const float sm = v0 + v1; const float incl = wave_scan_add(sm, l);
        inclL[h * 128 + 2 * l] = incl - v1; inclL[h * 128 + 2 * l + 1] = incl;
        const float* gq = A.in[I_FQG] + h * 128 + 2 * l; const float* gk = A.in[I_FKG] + h * 128 + 2 * l;
        const float gqm = wave_max(fmaxf(fabsf(gq[0]), fabsf(gq[1]))), gkm = wave_max(fmaxf(fabsf(gk[0]), fabsf(gk[1])));
        if (l == 0) thL[h] = 106.f + 2.f * 11.313708498984761f * gqm * gkm * 1.02f;
    }
    {
        const float g0 = SC[h * 128 + 2 * l], g1 = SC[h * 128 + 2 * l + 1], a0 = SC[1024 + h * 128 + 2 * l], a1 = SC[1024 + h * 128 + 2 * l + 1];
        const float gi1 = wave_scan_add(g0 + g1, l), gi0 = gi1 - g1, gx0 = gi0 - g0;
        const float val0 = a0 - gi0, val1 = a1 - gi1;
        const float pmi = wave_scan_max(fmaxf(val0, val1), l); float pme = __shfl_up(pmi, 1); if (l == 0) pme = -INFINITY;
        const float M0 = fmaxf(0.f, pme), M1 = fmaxf(M0, val0), M2 = fmaxf(M1, val1);
        const float m0 = M0 + gx0, m1 = M1 + gi0, m2 = M2 + gi1;
        decL[h * 128 + 2 * l] = expf(g0 + m0 - m1); sclL[h * 128 + 2 * l] = expf(a0 - m1);
        decL[h * 128 + 2 * l + 1] = expf(g1 + m1 - m2); sclL[h * 128 + 2 * l + 1] = expf(a1 - m2);
        if (F.vcu == 0) { float* MST = (float*)(ws + WS_SC) + 3072; MST[h * 128 + 2 * l] = m0; MST[h * 128 + 2 * l + 1] = m1; }
    }
    __syncthreads();
    int mycost = 0;
    if (F.tid < 256) { const int i = F.tid, hh = i >> 5, qb = i & 31; const float fref = qb ? inclL[hh * 128 + 4 * qb - 1] : 0.f, th = thL[hh];
        int lo = 0, hi2 = 4 * qb;
        while (lo < hi2) { const int mid = (lo + hi2) >> 1; if (fref - inclL[hh * 128 + mid] < -th) lo = mid + 1; else hi2 = mid; }
        jloL[i] = lo; mycost = 4 * (qb + 1) - lo; costL[i] = mycost; }
    {
        LAS int* wtot = prefL + 260;
        const int incl = (int)wave_scan_add((float)mycost, l);
        if (F.tid < 256 && l == 63) wtot[F.wave] = incl;
        __syncthreads();
        if (F.tid < 256) { int off = 0; for (int w = 0; w < F.wave; ++w) off += wtot[w]; prefL[F.tid] = off + incl - mycost; if (F.tid == 255) prefL[256] = off + incl; }
    }
    __syncthreads();
    {
        LAS int* ownL = (LAS int*)(F.lds + T_OWN);
        const int total = prefL[256]; int ge = total / 9; if (ge > F.G) ge = F.G; if (ge < 1) ge = 1;
        if (F.tid < 256) { const int i = F.tid; const int o0 = fox_owner(prefL[i], total, ge); ownL[i] = o0;
            if (F.vcu == 0) ((int*)(ws + WS_NPART))[i] = fox_owner(prefL[i] + mycost - 1, total, ge) - o0 + 1; }
        if (F.tid == 0) { ownL[256] = total; ownL[257] = ge; ownL[258] = (int)((long)total * F.vcu / ge); ownL[259] = (int)((long)total * (F.vcu + 1) / ge); }
    }
    __syncthreads();
}
__device__ __forceinline__ void ph5_m2(const Frame& F, const Args& A) {
    unsigned char* ws = A.ws;
    const LAS float* decL = (const LAS float*)(F.lds + T_DEC); const LAS float* sclL = (const LAS float*)(F.lds + T_SCL);
    LAS float* seg = (LAS float*)(F.lds + RING_OFF);
    const bf16* U = (const bf16*)(ws + WS_U); const float* UN = (const float*)(ws + WS_UN); bf16* CST = (bf16*)(ws + WS_CST); float* NST = (float*)(ws + WS_NST);
    const int g = F.wave, l = F.lane;
    constexpr int NT_C = 8 * 8192 / 128;
    for (int task0 = F.vcu; task0 < NT_C; task0 += 2 * F.G) {
        const bool hasB = task0 + F.G < NT_C;
        const int ttA = task0, ttB = hasB ? task0 + F.G : task0;
        const int hA = ttA >> 6, rA = (ttA * 128 + 2 * l) & 8191, jA = ttA & 63, hB = ttB >> 6, rB = (ttB * 128 + 2 * l) & 8191, jB = ttB & 63;
        const bf16* srcA = U + (size_t)hA * 128 * 8192 + rA; const bf16* srcB = U + (size_t)hB * 128 * 8192 + rB;
        const float* snA = UN + (size_t)hA * 128 * 64 + jA; const float* snB = UN + (size_t)hB * 128 * 64 + jB;
        f32x2_t uA[16], uB[16]; float nA[16], nB[16];
#pragma unroll
        for (int i = 0; i < 16; ++i) { const unsigned wa = *(const unsigned*)(srcA + (size_t)(16 * g + i) * 8192), wb = *(const unsigned*)(srcB + (size_t)(16 * g + i) * 8192);
            uA[i] = (f32x2_t){bflo(wa), bfhi(wa)}; uB[i] = (f32x2_t){bflo(wb), bfhi(wb)};
            nA[i] = snA[(16 * g + i) * 64]; nB[i] = snB[(16 * g + i) * 64]; }
        float ApA = 1.f, ApB = 1.f, BnA = 0.f, BnB = 0.f; f32x2_t BpA = {0.f, 0.f}, BpB = {0.f, 0.f};
#pragma unroll
        for (int i = 0; i < 16; ++i) { const float dA = decL[hA * 128 + 16 * g + i], sA = sclL[hA * 128 + 16 * g + i], dB = decL[hB * 128 + 16 * g + i], sB = sclL[hB * 128 + 16 * g + i];
            ApA *= dA; BpA = BpA * dA + uA[i] * sA; BnA = BnA * dA + nA[i] * sA; ApB *= dB; BpB = BpB * dB + uB[i] * sB; BnB = BnB * dB + nB[i] * sB; }
        seg[g * 128 + 2 * l] = ApA; seg[1024 + g * 128 + 2 * l] = BpA.x; seg[1024 + g * 128 + 2 * l + 1] = BpA.y; seg[2048 + g * 64 + l] = BnA;
        seg[3072 + g * 128 + 2 * l] = ApB; seg[3072 + 1024 + g * 128 + 2 * l] = BpB.x; seg[3072 + 1024 + g * 128 + 2 * l + 1] = BpB.y; seg[3072 + 2048 + g * 64 + l] = BnB;
        __syncthreads();
        f32x2_t stA = {0.f, 0.f}, stB = {0.f, 0.f}; float snsA = 0.f, snsB = 0.f;
        for (int q = 0; q < g; ++q) { const float a = seg[q * 128 + 2 * l], b = seg[3072 + q * 128 + 2 * l];
            stA.x = stA.x * a + seg[1024 + q * 128 + 2 * l]; stA.y = stA.y * a + seg[1024 + q * 128 + 2 * l + 1]; snsA = snsA * a + seg[2048 + q * 64 + l];
            stB.x = stB.x * b + seg[3072 + 1024 + q * 128 + 2 * l]; stB.y = stB.y * b + seg[3072 + 1024 + q * 128 + 2 * l + 1]; snsB = snsB * b + seg[3072 + 2048 + q * 64 + l]; }
        bf16* dA_ = CST + (size_t)hA * 128 * 8192 + rA; bf16* dB_ = CST + (size_t)hB * 128 * 8192 + rB;
        float* nsA = NST + (size_t)hA * 128 * 64 + jA; float* nsB = NST + (size_t)hB * 128 * 64 + jB;
#pragma unroll
        for (int i = 0; i < 16; ++i) { const float dA = decL[hA * 128 + 16 * g + i], sA = sclL[hA * 128 + 16 * g + i], dB = decL[hB * 128 + 16 * g + i], sB = sclL[hB * 128 + 16 * g + i];
            *(unsigned*)(dA_ + (size_t)(16 * g + i) * 8192) = pk2(stA.x, stA.y); if (l == 0) nsA[(16 * g + i) * 64] = snsA;
            stA = stA * dA + uA[i] * sA; snsA = snsA * dA + nA[i] * sA;
            if (hasB) { *(unsigned*)(dB_ + (size_t)(16 * g + i) * 8192) = pk2(stB.x, stB.y); if (l == 0) nsB[(16 * g + i) * 64] = snsB; }
            stB = stB * dB + uB[i] * sB; snsB = snsB * dB + nB[i] * sB; }
        __syncthreads();
    }
}

__device__ __forceinline__ void fox_fill_bias(const Frame& F, const Args& A, char* lds, int h, int klo, int khi) {
    int tid = threadIdx.x; asm volatile("" : "+v"(tid));
    const float* FLOC = (const float*)(A.ws + WS_FLOC);
    const float* inclL = (const float*)(lds + T_INCL); float* biasL = (float*)(lds + fox::ATT_BIAS_OFF);
    for (int s = klo + tid; s < khi; s += 512) { const int c = s >> 6; const float off = c ? inclL[h * 128 + c - 1] : 0.f;
        biasL[s] = -(off + FLOC[h * S_ + s]) * 11.313708498984761f; }
    __syncthreads();
}
__device__ __forceinline__ void ph5_attention(const Frame& F, const Args& A, char* lds) {
    using fbf = fox::bf16;
    unsigned char* ws = A.ws;
    const fbf* QF = (const fbf*)(ws + WS_QF); const fbf* KF = (const fbf*)(ws + WS_KF); const fbf* VZ = (const fbf*)(ws + WS_Z) + 5120;
    fbf* PO = (fbf*)(ws + WS_PO); float* PML = (float*)(ws + WS_PML);
    const int* costL = (const int*)(lds + T_COST); const int* prefL = (const int*)(lds + T_PREF); const int* jloL = (const int*)(lds + T_JLO);
    const int* ownL = (const int*)(lds + T_OWN);
    const int ge = __builtin_amdgcn_readfirstlane(ownL[257]);
    if (F.vcu >= ge) return;
    const int start = __builtin_amdgcn_readfirstlane(ownL[258]), end = __builtin_amdgcn_readfirstlane(ownL[259]);
    if (end <= start) return;
    int i = 0; { int lo = 0, hi = 255; while (lo < hi) { const int mid = (lo + hi + 1) >> 1; if (prefL[mid] <= start) lo = mid; else hi = mid - 1; } i = lo; }
#define FOX_RANGE(ii, ja_, jb_, h_, qb_, p_) do { h_ = (ii) >> 5; qb_ = (ii) & 31; const int ex_ = prefL[ii]; ja_ = jloL[ii] + (start > ex_ ? start - ex_ : 0); \
        jb_ = jloL[ii] + ((end - ex_ < costL[ii]) ? end - ex_ : costL[ii]); p_ = F.vcu - ownL[ii]; } while (0)
#define FOX_REF(hh, qb, ja_, jb_, pp) fox::BlockRef<fbf, fbf>{QF + (size_t)(qb) * 256 * 1024 + (hh) * 128, KF + (hh) * 128, VZ + (hh) * 128, (fbf*)nullptr, (qb) * 256, ja_, jb_, \
        PO + ((size_t)((hh) * 32 + (qb)) * MAXP + (pp)) * 32768, PML + ((size_t)((hh) * 32 + (qb)) * MAXP + (pp)) * 512}
    int h, qb, ja, jb, p; FOX_RANGE(i, ja, jb, h, qb, p);
    fox::BlockRef<fbf, fbf> cur = FOX_REF(h, qb, ja, jb, p);
    fox::Seam<fbf> S;
    int cur_h = -1;
#pragma unroll 1
    for (;;) {
        if (h != cur_h) {
            int tlo = ja, thi = jb;
            for (int ii = i + 1; ii < 256 && (ii >> 5) == h && prefL[ii] < end; ++ii) { const int a2 = jloL[ii], b2 = jloL[ii] + ((end - prefL[ii] < costL[ii]) ? end - prefL[ii] : costL[ii]); tlo = a2 < tlo ? a2 : tlo; thi = b2 > thi ? b2 : thi; }
            fox_fill_bias(F, A, lds, h, tlo * 64, thi * 64); fox::causal_swa_prime<fbf, fbf>(cur, fox::SKV, lds, S); cur_h = h; }
        const bool more = (i + 1 < 256) && (prefL[i + 1] < end);
        int hn = h, qbn = qb, jan = ja, jbn = jb, pn = p;
        if (more) FOX_RANGE(i + 1, jan, jbn, hn, qbn, pn);
        const bool chain = more && hn == h;
        const fox::BlockRef<fbf, fbf> nxt = chain ? FOX_REF(hn, qbn, jan, jbn, pn) : cur;
        fox::causal_swa_block<fbf, fbf>(cur, nxt, fox::SKV, fox::SKV, lds, S);
        if (!more) break;
        ++i; h = hn; qb = qbn; ja = jan; jb = jbn; p = pn; cur = chain ? nxt : FOX_REF(h, qb, ja, jb, p);
    }
#undef FOX_REF
#undef FOX_RANGE
}

__device__ __forceinline__ void ph6_unit(const Frame& F, const Args& A, int c, int h) {
    unsigned char* ws = A.ws;
    const bf16* Z = (const bf16*)(ws + WS_Z);
    LAS unsigned char* Vt = F.lds + RING_OFF;
    LAS bf16* Qb = (LAS bf16*)(Vt + 16384);
    LAS bf16* Kb = Qb + 64 * LP;
    LAS bf16* Sb = Kb + 64 * LP;
    LAS bf16* Cb = Sb + 64 * LP;
    LAS float* fl = (LAS float*)(Cb + 128 * LP);
    LAS float* btm = fl, *ibs = fl + 64, *mtL = fl + 128, *wiL = fl + 192, *nL = fl + 256, *qnL = fl + 320, *denS = fl + 384  , *ssq = fl + 512  ;
    const int t0 = c * 64, tid = F.tid, lane = F.lane, r32 = lane & 31, hi = lane >> 5;
    {
        const v4u* Qg = (const v4u*)((const bf16*)(ws + WS_QM) + ((size_t)h * S_ + t0) * 64); const v4u* Kg = (const v4u*)((const bf16*)(ws + WS_KM) + ((size_t)h * S_ + t0) * 64);
        const v4u* Cg = (const v4u*)((const bf16*)(ws + WS_CST) + ((size_t)h * 128 + c) * 8192);
        const v4u q4 = Qg[tid], k4 = Kg[tid], c40 = Cg[tid], c41 = Cg[tid + 512];
        v4u vv[2];
#pragma unroll
        for (int i = 0; i < 2; ++i) { const int idx = tid + 512 * i, sx = idx >> 4, c8 = (idx & 15) * 8; vv[i] = *(const v4u*)(Z + (size_t)(t0 + sx) * pg8::ZLD + 1024 + h * 128 + c8); }
        const float mprev = ((const float*)(ws + WS_SC))[3072 + h * 128 + c];
        if (F.wave == 0) { const float b = ((const float*)(ws + WS_BL))[h * S_ + t0 + lane], ip = ((const float*)(ws + WS_IPL))[h * S_ + t0 + lane];
            const float pm = wave_scan_max(ip - b, lane); const float mt = b + fmaxf(mprev, pm);
            mtL[lane] = mt; wiL[lane] = expf(b + mprev - mt); btm[lane] = b - mt; ibs[lane] = ip - b;
            nL[lane] = ((const float*)(ws + WS_NST))[((size_t)h * 128 + c) * 64 + lane]; }
        *(LAS v4u*)(Qb + (tid >> 3) * LP + (tid & 7) * 8) = q4; *(LAS v4u*)(Kb + (tid >> 3) * LP + (tid & 7) * 8) = k4;
        *(LAS v4u*)(Cb + (tid >> 3) * LP + (tid & 7) * 8) = c40; *(LAS v4u*)(Cb + (64 + (tid >> 3)) * LP + (tid & 7) * 8) = c41;
#pragma unroll
        for (int i = 0; i < 2; ++i) { const int idx = tid + 512 * i, sx = idx >> 4, c8 = (idx & 15) * 8; *(LAS v4u*)(Vt + fox::v_st(sx, c8)) = vv[i]; }
    }
    __syncthreads();
    if (F.wave < 4) {
        const int sb = F.wave >> 1, tb = F.wave & 1;
        fox::f32x16 acc = {};
        mm_row_row(acc, Kb + (32 * sb + r32) * LP + 8 * hi, Qb + (32 * tb + r32) * LP + 8 * hi);
        const int t = 32 * tb + r32; const float bt = btm[t]; float ps = 0.f;
#pragma unroll
        for (int g = 0; g < 4; ++g) { const int sg = 32 * sb + 8 * g + 4 * hi; const f32x4 ib = *(const LAS f32x4*)(ibs + sg);
            float w[4];
#pragma unroll
            for (int q = 0; q < 4; ++q) { const float v = (sg + q <= t) ? acc[4 * g + q] * __builtin_amdgcn_exp2f(1.4426950408889634f * (bt + ib[q])) : 0.f; w[q] = v; ps += v; }
            v2u pk; pk.x = pk2(w[0], w[1]); pk.y = pk2(w[2], w[3]); *(LAS v2u*)(Sb + t * LP + sg) = pk; }
        ps += __shfl_xor(ps, 32);
        if (hi == 0) denS[sb * 64 + t] = ps;
    } else {
        const int j = tid - 256, t = j >> 2, dq = (j & 3) * 16; float qn = 0.f;
#pragma unroll
        for (int i = 0; i < 16; ++i) qn += pg8::bf2f(Qb[t * LP + dq + i]) * nL[dq + i];
        qn += __shfl_xor(qn, 1); qn += __shfl_xor(qn, 2);
        if ((j & 3) == 0) qnL[t] = qn;
    }
    __syncthreads();
    const int eb = F.wave >> 1, tb = F.wave & 1, t = 32 * tb + r32;
    fox::f32x16 accS = {}, accC = {};
    {
        const int ta = (int)(uintptr_t)Vt + fox::v_rd_base(lane);
        const LAS bf16* srow = Sb + t * LP + 8 * hi;
        if (eb == 0) mm_tr_row<0>(accS, ta, srow); else if (eb == 1) mm_tr_row<1>(accS, ta, srow); else if (eb == 2) mm_tr_row<2>(accS, ta, srow); else mm_tr_row<3>(accS, ta, srow);
        mm_row_row(accC, Cb + (32 * eb + r32) * LP + 8 * hi, Qb + t * LP + 8 * hi);
    }
    const float mt = mtL[t], wi = wiL[t];
    const float den = denS[t] + denS[64 + t] + wi * qnL[t];
    const float inv = __builtin_amdgcn_rcpf(fmaxf(fabsf(den), expf(-mt)));
    float o[16]; float ss = 0.f;
#pragma unroll
    for (int i = 0; i < 16; ++i) { o[i] = (accS[i] + wi * accC[i]) * inv; ss += o[i] * o[i]; }
    ss += __shfl_xor(ss, 32);
    if (hi == 0) ssq[eb * 64 + t] = ss;
    __syncthreads();
    const float r = 1.f / sqrtf((ssq[t] + ssq[64 + t] + ssq[128 + t] + ssq[192 + t]) * (1.f / 128.f) + EPS_);
    const float* mg = A.in[I_MONG] + h * 128 + 32 * eb + 4 * hi;
    const unsigned char* og = ws + WS_Z8 + (size_t)(t0 + t) * pg8::Z8LD + h * 128 + 32 * eb + 4 * hi;
    bf16* hm = (bf16*)(ws + WS_HMF) + (size_t)(t0 + t) * 2048 + h * 128 + 32 * eb + 4 * hi;
#pragma unroll
    for (int g = 0; g < 4; ++g) { const unsigned ow = *(const unsigned*)(og + 8 * g); const f32x4 gm = *(const f32x4*)(mg + 8 * g);
        const auto o01 = __builtin_amdgcn_cvt_pk_f32_fp8((int)ow, false), o23 = __builtin_amdgcn_cvt_pk_f32_fp8((int)ow, true);
        uint2 pw; pw.x = pk2(o[4 * g] * r * gm.x * sigm(o01[0]), o[4 * g + 1] * r * gm.y * sigm(o01[1]));
        pw.y = pk2(o[4 * g + 2] * r * gm.z * sigm(o23[0]), o[4 * g + 3] * r * gm.w * sigm(o23[1]));
        *(uint2*)(hm + 8 * g) = pw; }
    __syncthreads();
}
__device__ __forceinline__ float rdl(float v, int l) { return __builtin_bit_cast(float, __builtin_amdgcn_readlane(__builtin_bit_cast(int, v), l)); }
__device__ __forceinline__ void ph6_hf(const Frame& F, const Args& A) {
    const bf16* PO = (const bf16*)(A.ws + WS_PO); const float* PML = (const float*)(A.ws + WS_PML); const int* NPART = (const int*)(A.ws + WS_NPART);
    const bf16* Z = (const bf16*)(A.ws + WS_Z); bf16* HF = (bf16*)(A.ws + WS_HMF) + 1024;
    constexpr float C2 = 1.4426950408889634f * 0.08838834764831845f;
    const int gw = F.vcu * NWAVES + F.wave, NGW = F.G * NWAVES, lane = F.lane;
    const int mlo = (lane & 7) + ((lane & 8) ? 256 : 0);
#pragma unroll 1
    for (int g = gw; g < S_; g += NGW) {
        const int h = g & 7, row0 = (g >> 3) * 8, blk = h * 32 + (row0 >> 8), rr0 = row0 & 255;
        const int np = __builtin_amdgcn_readfirstlane(NPART[blk]);
        const float* pm = PML + (size_t)blk * MAXP * 512 + rr0 + mlo; const bf16* po = PO + (size_t)blk * MAXP * 32768 + (size_t)rr0 * 128 + 2 * lane;
        unsigned gz[8], ov[8]; float M[8], L[8]; f32x2_t a[8];
        { const float ml = pm[0];
#pragma unroll
          for (int q = 0; q < 8; ++q) { ov[q] = *(const unsigned*)(po + q * 128); gz[q] = *(const unsigned short*)(A.ws + WS_Z8 + (size_t)(row0 + q) * pg8::Z8LD + 1024 + h * 128 + 2 * lane); }
#pragma unroll
          for (int q = 0; q < 8; ++q) { M[q] = rdl(ml, q); L[q] = rdl(ml, 8 + q); a[q].x = bflo(ov[q]); a[q].y = bfhi(ov[q]); } }
#pragma unroll 1
        for (int p = 1; p < np; ++p) { const float ml = pm[(size_t)p * 512];
#pragma unroll
            for (int q = 0; q < 8; ++q) ov[q] = *(const unsigned*)(po + (size_t)p * 32768 + q * 128);
#pragma unroll
            for (int q = 0; q < 8; ++q) { const float mp = rdl(ml, q), lp = rdl(ml, 8 + q);
                const float Mn = fmaxf(M[q], mp), w0 = __builtin_amdgcn_exp2f((M[q] - Mn) * C2), w1 = __builtin_amdgcn_exp2f((mp - Mn) * C2);
                L[q] = L[q] * w0 + lp * w1; a[q].x = a[q].x * w0 + bflo(ov[q]) * w1; a[q].y = a[q].y * w0 + bfhi(ov[q]) * w1; M[q] = Mn; } }
#pragma unroll
        for (int q = 0; q < 8; ++q) { const float inv = __builtin_amdgcn_rcpf(L[q]); const auto gq2 = __builtin_amdgcn_cvt_pk_f32_fp8((int)gz[q], false);
            *(unsigned*)(HF + (size_t)(row0 + q) * 2048 + h * 128 + 2 * lane) = pk2(a[q].x * inv * sigm(gq2[0]), a[q].y * inv * sigm(gq2[1])); }
    }
}

__device__ __forceinline__ void ph9_router(const Frame& F, const Args& A) {
    unsigned char* ws = A.ws;
    const float* X1 = A.in[I_X]; const bf16* DX = (const bf16*)(ws + WS_XN); const float* g2n = A.in[I_N2G]; const float* MOD = (const float*)(ws + WS_MOD); const float* WRT = (const float*)(ws + WS_WRT); const float* br = A.in[I_BR];
    unsigned char* XGE = (unsigned char*)(ws + WS_XGE); float* SWE = (float*)(ws + WS_SWE); int* EIDX = (int*)(ws + WS_EIDX); int* ESLOT = (int*)(ws + WS_ESLOT);
    unsigned* CNT = (unsigned*)(ws + WS_CTL) + CW_CNT;
    LAS f32x4* wl = (LAS f32x4*)(F.lds + RING_OFF);
    LAS unsigned* cntL = (LAS unsigned*)(F.lds + LDSCTL_OFF + 1280);
    LAS unsigned* baseL = cntL + 32;
    for (int grp = F.vcu; grp < S_ / 32; grp += F.G) {
        int lane = F.lane; asm volatile("" : "+v"(lane));
        const int tid = F.wave * 64 + lane;
        const int r0 = grp * 32 + F.wave * 4;
        if (tid < 32) cntL[tid] = 0u;
        f32x4 hv[4][8];
        { f32x4 t16[16];
#pragma unroll
          for (int i = 0; i < 16; ++i) t16[i] = ((const f32x4*)WRT)[tid + 512 * i];
          __builtin_amdgcn_sched_barrier(0);
#pragma unroll
          for (int r = 0; r < 4; ++r) { const f32x4* xr = (const f32x4*)(X1 + (size_t)(r0 + r) * DM) + lane;
#pragma unroll
              for (int j = 0; j < 8; ++j) hv[r][j] = xr[64 * j]; }
          __builtin_amdgcn_sched_barrier(0);
#pragma unroll
          for (int i = 0; i < 16; ++i) wl[tid + 512 * i] = t16[i]; }
        __builtin_amdgcn_sched_barrier(0);
#pragma unroll
        for (int r = 0; r < 4; ++r) { const uint2* dr = (const uint2*)(DX + (size_t)(r0 + r) * DM) + lane; uint2 dw[8];
#pragma unroll
            for (int j = 0; j < 8; ++j) dw[j] = dr[64 * j];
#pragma unroll
            for (int j = 0; j < 8; ++j) { hv[r][j].x += bflo(dw[j].x); hv[r][j].y += bfhi(dw[j].x); hv[r][j].z += bflo(dw[j].y); hv[r][j].w += bfhi(dw[j].y); } }
        float rstd[4];
#pragma unroll
        for (int r = 0; r < 4; ++r) { float ss = 0.f;
#pragma unroll
            for (int j = 0; j < 8; ++j) ss += (hv[r][j].x * hv[r][j].x + hv[r][j].y * hv[r][j].y) + (hv[r][j].z * hv[r][j].z + hv[r][j].w * hv[r][j].w);
            rstd[r] = 1.f / sqrtf(wave_sum(ss) * (1.f / DM) + EPS_); }
#pragma unroll
        for (int j = 0; j < 8; ++j) { const int col = 4 * lane + 256 * j;
            const f32x4 g = *(const f32x4*)(g2n + col), sh = *(const f32x4*)(MOD + 6144 + col), sc = *(const f32x4*)(MOD + 8192 + col);
            const f32x4 gs1 = g * (sc + 1.f);
#pragma unroll
            for (int r = 0; r < 4; ++r) hv[r][j] = hv[r][j] * rstd[r] * gs1 + sh;
            __builtin_amdgcn_sched_barrier(0); }
        float lgv[2];
#pragma unroll 1
        for (int half = 0; half < 2; ++half) {
            if (half == 1) { __syncthreads();
              const f32x4* src = (const f32x4*)(WRT + (size_t)16 * DM);
#pragma unroll 1
              for (int i0 = 0; i0 < 16; i0 += 8) { f32x4 t8[8];
#pragma unroll
                for (int i = 0; i < 8; ++i) t8[i] = src[tid + 512 * (i0 + i)];
#pragma unroll
                for (int i = 0; i < 8; ++i) wl[tid + 512 * (i0 + i)] = t8[i]; } }
            __syncthreads();
            float mine = 0.f;
            const bool b0 = lane & 1, b1 = lane & 2, b4 = lane & 16, b5 = lane & 32;
#pragma unroll 1
            for (int g = 0; g < 4; ++g) { float q[4][4];
#pragma unroll
                for (int el = 0; el < 4; ++el) { f32x4 a0 = {0.f, 0.f, 0.f, 0.f}, a1 = a0, a2 = a0, a3 = a0;
#pragma unroll
                    for (int j = 0; j < 8; ++j) { const f32x4 w = wl[(4 * g + el) * 512 + lane + 64 * j];
                        a0 += hv[0][j] * w; a1 += hv[1][j] * w; a2 += hv[2][j] * w; a3 += hv[3][j] * w; }
                    q[0][el] = (a0.x + a0.y) + (a0.z + a0.w); q[1][el] = (a1.x + a1.y) + (a1.z + a1.w); q[2][el] = (a2.x + a2.y) + (a2.z + a2.w); q[3][el] = (a3.x + a3.y) + (a3.z + a3.w); }
                float s1[2][4], s2[4], s3[2];
#pragma unroll
                for (int k = 0; k < 2; ++k)
#pragma unroll
                    for (int el = 0; el < 4; ++el) { const float keep = b4 ? q[2 * k + 1][el] : q[2 * k][el], send = b4 ? q[2 * k][el] : q[2 * k + 1][el]; s1[k][el] = keep + __shfl_xor(send, 16); }
#pragma unroll
                for (int el = 0; el < 4; ++el) { const float keep = b5 ? s1[1][el] : s1[0][el], send = b5 ? s1[0][el] : s1[1][el]; s2[el] = keep + __shfl_xor(send, 32); }
#pragma unroll
                for (int k = 0; k < 2; ++k) { const float keep = b0 ? s2[2 * k + 1] : s2[2 * k], send = b0 ? s2[2 * k] : s2[2 * k + 1]; s3[k] = keep + __shfl_xor(send, 1); }
                float s4; { const float keep = b1 ? s3[1] : s3[0], send = b1 ? s3[0] : s3[1]; s4 = keep + __shfl_xor(send, 2); }
                s4 += __shfl_xor(s4, 4); s4 += __shfl_xor(s4, 8);
                if (((lane >> 2) & 3) == g) mine = s4; }
            const float tot = mine + br[half * 16 + (lane & 15)];
            if (half == 0) lgv[0] = tot; else lgv[1] = tot;
        }
        unsigned pk[4][8];
#pragma unroll
        for (int r = 0; r < 4; ++r)
#pragma unroll
            for (int j = 0; j < 8; ++j) pk[r][j] = pg8::pack_fp8x4(hv[r][j].x, hv[r][j].y, hv[r][j].z, hv[r][j].w);
        float va = lgv[0], vb = lgv[1]; float tv[4]; int ti[4];
#pragma unroll
        for (int k = 0; k < 4; ++k) { float bv = va >= vb ? va : vb; int bi = va >= vb ? (lane & 15) : 16 + (lane & 15);
#pragma unroll
            for (int o = 1; o < 16; o <<= 1) { const float ov = __shfl_xor(bv, o); const int oi = __shfl_xor(bi, o); const bool take = (ov > bv) || (ov == bv && oi < bi); bv = take ? ov : bv; bi = take ? oi : bi; }
            tv[k] = bv; ti[k] = bi; if ((bi & 15) == (lane & 15)) { if (bi < 16) va = -INFINITY; else vb = -INFINITY; } }
        const float e1 = expf(tv[1] - tv[0]), e2 = expf(tv[2] - tv[0]), e3 = expf(tv[3] - tv[0]); const float inv = 1.f / (1.f + e1 + e2 + e3);
        const float wv[4] = {inv, e1 * inv, e2 * inv, e3 * inv};
        unsigned lr[4] = {0u, 0u, 0u, 0u};
        const bool leader = (lane & 15) == 0;
        __syncthreads();
        if (leader) {
#pragma unroll
            for (int k = 0; k < 4; ++k) lr[k] = __hip_atomic_fetch_add(cntL + ti[k], 1u, __ATOMIC_RELAXED, __HIP_MEMORY_SCOPE_WORKGROUP); }
        __syncthreads();
        if (tid < 32) baseL[tid] = __hip_atomic_fetch_add(CNT + 64 * tid, cntL[tid], __ATOMIC_RELAXED, __HIP_MEMORY_SCOPE_AGENT);
        __syncthreads();
        int gs[4];
#pragma unroll
        for (int k = 0; k < 4; ++k) gs[k] = (int)(baseL[ti[k]] + lr[k]);
        if (leader) { const int row = r0 + (lane >> 4);
#pragma unroll
            for (int k = 0; k < 4; ++k) { EIDX[row * 4 + k] = ti[k]; ESLOT[row * 4 + k] = gs[k]; SWE[(size_t)ti[k] * 8192 + gs[k]] = wv[k]; } }
#pragma unroll
        for (int r = 0; r < 4; ++r) {
#pragma unroll
            for (int k = 0; k < 4; ++k) { const int e = __shfl(ti[k], 16 * r), sl = __shfl(gs[k], 16 * r);
                unsigned* o4 = (unsigned*)(XGE + ((size_t)e * 8448 + sl) * DM) + lane;
#pragma unroll
                for (int j = 0; j < 8; ++j) o4[64 * j] = pk[r][j]; } }
        __syncthreads();
    }
}

__device__ __forceinline__ void moe_tables(const Frame& F, const Args& A) {
    LAS int* EOFF = (LAS int*)(F.lds + EOFF_OFF); LAS int* TE = (LAS int*)(F.lds + TILE_E_OFF);
    if (F.wave == 0) {
        const unsigned* CNT = (const unsigned*)(A.ws + WS_CTL) + CW_CNT; const int e = F.lane;
        const int cnt = e < 32 ? (int)__hip_atomic_load(CNT + 64 * e, __ATOMIC_RELAXED, __HIP_MEMORY_SCOPE_AGENT) : 0;
        const int rem = cnt & 255, nf = (cnt >> 8) + (rem > 128 ? 1 : 0), nh = (rem > 0 && rem <= 128) ? 1 : 0, r128 = 2 * nf + nh;
        const int irow = (int)wave_scan_add((float)r128, e), ifull = (int)wave_scan_add((float)nf, e), ihalf = (int)wave_scan_add((float)nh, e);
        const int NF = __shfl(ifull, 63);
        if (e < 32) { EOFF[e] = (irow - r128) * 128;
            for (int i = 0; i < nf; ++i) TE[ifull - nf + i] = e | ((2 * i) << 9);
            if (nh) TE[NF + ihalf - 1] = e | (1 << 8) | ((2 * nf) << 9); }
        if (e == 63) { EOFF[32] = irow * 128; EOFF[33] = ifull + ihalf; }
    }
    __syncthreads();
}
__device__ __forceinline__ void ph13_final(const Frame& F, const Args& A) {
    unsigned char* ws = A.ws;
    const LAS int* EOFF = (const LAS int*)(F.lds + EOFF_OFF);
    const float* MOD = (const float*)(ws + WS_MOD); const float* fg = A.in[I_FNG]; const unsigned char* YS = ws + WS_YS;
    const int* EIDX = (const int*)(ws + WS_EIDX); const int* ESLOT = (const int*)(ws + WS_ESLOT); float* out = A.out;
    const int gw = F.vcu * NWAVES + F.wave, NGW = F.G * NWAVES, lane = F.lane;
    for (int row = gw; row < S_; row += NGW) {
        f32x4 v[8], mo[8];
        const f32x4* xr = (const f32x4*)(A.in[I_X] + (size_t)row * DM) + lane; const uint2* dr = (const uint2*)((const bf16*)(ws + WS_XN) + (size_t)row * DM) + lane;
#pragma unroll
        for (int j = 0; j < 8; ++j) { const f32x4 xv = xr[64 * j]; const uint2 dw = dr[64 * j];
            v[j].x = xv.x + bflo(dw.x); v[j].y = xv.y + bfhi(dw.x); v[j].z = xv.z + bflo(dw.y); v[j].w = xv.w + bfhi(dw.y); mo[j] = (f32x4){0.f, 0.f, 0.f, 0.f}; }
#pragma unroll
        for (int k = 0; k < 4; ++k) { const int dst = EOFF[EIDX[row * 4 + k]] + ESLOT[row * 4 + k]; const unsigned* yr = (const unsigned*)(YS + (size_t)dst * DM) + lane;
#pragma unroll
            for (int j = 0; j < 8; ++j) { const unsigned w = yr[64 * j]; const auto lo2 = __builtin_amdgcn_cvt_pk_f32_fp8((int)w, false), hi2 = __builtin_amdgcn_cvt_pk_f32_fp8((int)w, true);
                mo[j].x += lo2[0]; mo[j].y += lo2[1]; mo[j].z += hi2[0]; mo[j].w += hi2[1]; } }
        float ss = 0.f;
#pragma unroll
        for (int j = 0; j < 8; ++j) { const f32x4 g2 = *(const f32x4*)(MOD + 10240 + 4 * lane + 256 * j) * 0.03125f; v[j] = v[j] + g2 * mo[j];
            ss += (v[j].x * v[j].x + v[j].y * v[j].y) + (v[j].z * v[j].z + v[j].w * v[j].w); }
        const float rstd = 1.f / sqrtf(wave_sum(ss) * (1.f / DM) + EPS_);
        f32x4* orow = (f32x4*)(out + (size_t)row * DM) + lane;
#pragma unroll
        for (int j = 0; j < 8; ++j) { const f32x4 g = *(const f32x4*)(fg + 4 * lane + 256 * j); orow[64 * j] = v[j] * rstd * g; }
    }
}

#ifndef PG8_SP2
#define PG8_SP2 true
#endif
#ifndef PG8_ALIGN
#define PG8_ALIGN true
#endif
__global__ void __launch_bounds__(NWAVES * 64, 2) mk_fwd(Args args) {
    extern __shared__ __attribute__((aligned(16))) unsigned char lds[];
    Frame F;
    F.lds = (LAS unsigned char*)lds;
    F.tid = threadIdx.x; F.lane = F.tid & 63; F.wave = __builtin_amdgcn_readfirstlane(F.tid >> 6);
    F.G = gridDim.x; { const int bx = blockIdx.x; F.vcu = (F.G % 8 == 0) ? (bx % 8) * (F.G / 8) + bx / 8 : bx; }
    unsigned char* ws = args.ws;
    for (int u = F.tid; u < (LDS_BYTES - LDSCTL_OFF) / 4; u += NWAVES * 64) ((LAS unsigned*)(F.lds + LDSCTL_OFF))[u] = 0u;
    __syncthreads();
    XcdBarrier bar; bar.bar = (unsigned*)(ws + WS_CTL) + CW_BAR; bar.x = 0; bar.st = nullptr;
    if (N_LAUNCHES == 1) bar = xcd_barrier_post((unsigned*)(ws + WS_CTL) + CW_BAR, (volatile LAS unsigned*)(F.lds + MISC_OFF) + 8);
    const int lo = args.ph_lo, hi = args.ph_hi;
#ifdef MK_ONLY
#define IN(k) ((k) == MK_ONLY && lo <= (k) && (k) < hi)
#else
#define IN(k) (lo <= (k) && (k) < hi)
#endif
#define SEAM(k) do { if (IN(k) && IN((k) + 1 + ((k) == 9))) xcd_barrier(bar); } while (0)
#define FENCE_IDS() do { int t_ = threadIdx.x; asm volatile("" : "+v"(t_)); F.tid = t_; F.lane = t_ & 63; } while (0)

    if (IN(0)) { FENCE_IDS(); ph0_prologue(F, args); } SEAM(0);
    if (IN(1)) { FENCE_IDS(); ph1_modreduce(F, args); } SEAM(1);
    if (IN(2)) { FENCE_IDS(); ph2_norm1(F, args); } SEAM(2);
    if (IN(3)) { FENCE_IDS();
        const int gw3 = (F.G == 256) ? GW3 : F.G;
        if ((int)blockIdx.x < gw3) {
            { pg8::Gemm g{(const pg8::bf16_t*)(ws + WS_XN), (const pg8::bf16_t*)(ws + WS_WINT), S_, NZT, DM}; pg8::InOrderBf S; S.init(S_, 21 * 256, gw3, (int)blockIdx.x);
              pg8::EpiZ E{(pg8::bf16_t*)(ws + WS_Z), (float*)(ws + WS_G24), 1.f, nullptr};
              pg8::gemm_phase<pg8::EpiZ, pg8::InOrderBf, PG8_ALIGN, PG8_SP2>(F.lds + RING_OFF, g, S, E); }
            { pg8::Gemm g{(const pg8::bf16_t*)(ws + WS_XN8), (const pg8::bf16_t*)(ws + WS_WINT8), S_, NZT, DM}; pg8::InOrderF8 S; S.init(S_, 24 * 256, gw3, (int)blockIdx.x);
              pg8::EpiZ E{(pg8::bf16_t*)(ws + WS_Z), (float*)(ws + WS_G24), 0.015625f, ws + WS_Z8};
              pg8::gemm_phase<pg8::EpiZ, pg8::InOrderF8, PG8_ALIGN, PG8_SP2, true>(F.lds + RING_OFF, g, S, E); }
        }
        moe_convert_queue(F, args);
    } SEAM(3);
    if (IN(4)) { FENCE_IDS(); for (int u = F.vcu; u < 1024; u += F.G) ph4_unit(F, args, u >> 3, u & 7); } SEAM(4);
    if (IN(5)) { FENCE_IDS();
        ph5_tables(F, args); ph5_m2(F, args); ph5_attention(F, args, (char*)lds);
    } SEAM(5);
    if (IN(6)) { FENCE_IDS(); for (int u = F.vcu; u < 1024; u += F.G) ph6_unit(F, args, u >> 3, u & 7); ph6_hf(F, args); } SEAM(6);
    if (IN(7)) { FENCE_IDS();
        pg8::Gemm g{(const pg8::bf16_t*)(ws + WS_HMF), (const pg8::bf16_t*)(ws + WS_WMT), S_, DM, 2048}; pg8::StaticOrder S; S.init(S_, DM, F.G, (int)blockIdx.x);
        pg8::EpiBranch E{(pg8::bf16_t*)(ws + WS_Y), (const unsigned char*)(ws + WS_Z8), 2048, 4096};
        pg8::gemm_phase<pg8::EpiBranch, pg8::StaticOrder, PG8_ALIGN, PG8_SP2>(F.lds + RING_OFF, g, S, E);
    } SEAM(7);
    if (IN(8)) { FENCE_IDS();
        pg8::Gemm g{(const pg8::bf16_t*)(ws + WS_Y), (const pg8::bf16_t*)(ws + WS_WOUTT), S_, DM, DM}; pg8::StaticOrder S; S.init(S_, DM, F.G, (int)blockIdx.x);
        pg8::EpiDelta E{(pg8::bf16_t*)(ws + WS_XN), (const float*)(ws + WS_MOD) + 4096};
        pg8::gemm_phase<pg8::EpiDelta, pg8::StaticOrder, PG8_ALIGN, PG8_SP2>(F.lds + RING_OFF, g, S, E);
    } SEAM(8);
    if (IN(9)) { FENCE_IDS(); ph9_router(F, args); } SEAM(9);
    if (IN(11)) { FENCE_IDS();
        moe_tables(F, args);
        const int nt = __builtin_amdgcn_readfirstlane(((const LAS int*)(F.lds + EOFF_OFF))[33]);
        pg8::Gemm g{(const pg8::bf16_t*)(ws + WS_XGE), (const pg8::bf16_t*)(ws + WS_WGUT), MPAD, 32 * 4096, DM};
        pg8::MoeOrder S{(const PG8_LAS int*)(F.lds + TILE_E_OFF), (const PG8_LAS int*)(F.lds + EOFF_OFF), nt, 16, F.G, (int)blockIdx.x, true};
        pg8::EpiSwiglu E{(unsigned char*)(ws + WS_ACT), args.in[I_BGU]};
        pg8::gemm_phase<pg8::EpiSwiglu, pg8::MoeOrder, PG8_ALIGN, PG8_SP2, true>(F.lds + RING_OFF, g, S, E);
    } SEAM(11);
    if (IN(12)) { FENCE_IDS();
        if (!IN(11)) moe_tables(F, args);
        const int nt = __builtin_amdgcn_readfirstlane(((const LAS int*)(F.lds + EOFF_OFF))[33]);
        pg8::Gemm g{(const pg8::bf16_t*)(ws + WS_ACT), (const pg8::bf16_t*)(ws + WS_WDT), MPAD, 32 * 2048, DFF};
        pg8::MoeOrder S{(const PG8_LAS int*)(F.lds + TILE_E_OFF), (const PG8_LAS int*)(F.lds + EOFF_OFF), nt, 8, F.G, (int)blockIdx.x, false};
        pg8::EpiDown E{(unsigned char*)(ws + WS_YS), args.in[I_BD], (const float*)(ws + WS_SWE), (const PG8_LAS int*)(F.lds + EOFF_OFF)};
        pg8::gemm_phase<pg8::EpiDown, pg8::MoeOrder, PG8_ALIGN, PG8_SP2, true>(F.lds + RING_OFF, g, S, E);
    } SEAM(12);
    if (IN(13)) { FENCE_IDS(); if (!IN(12)) moe_tables(F, args); ph13_final(F, args); }
#undef IN
#undef SEAM
}

extern "C" void kernel_launch(void* const* d_in, const int* in_sizes, int n_in, void* d_out, int out_size, void* d_ws, size_t ws_size, hipStream_t stream) {
    static int grid = 0;
    if (grid == 0) {
        if (n_in != 25 || in_sizes[0] != S_ * DM || out_size != S_ * DM || ws_size < WS_END) {
            fprintf(stderr, "kernel_launch: unexpected shapes (n_in %d, in0 %d, out %d, ws %zu); nothing launched\n", n_in, n_in > 0 ? in_sizes[0] : -1, out_size, ws_size); grid = -1; return; }
        int dev = 0, cus = 0, per_cu = 0;
        if (hipGetDevice(&dev) != hipSuccess || hipDeviceGetAttribute(&cus, hipDeviceAttributeMultiprocessorCount, dev) != hipSuccess) { grid = -1; return; }
        if (hipFuncSetAttribute((const void*)mk_fwd, hipFuncAttributeMaxDynamicSharedMemorySize, LDS_BYTES) != hipSuccess) { fprintf(stderr, "kernel_launch: hipFuncSetAttribute failed\n"); grid = -1; return; }
        if (hipOccupancyMaxActiveBlocksPerMultiprocessor(&per_cu, (const void*)mk_fwd, NWAVES * 64, LDS_BYTES) != hipSuccess || per_cu < 1)
            fprintf(stderr, "kernel_launch: note: occupancy query reports %d workgroups per CU\n", per_cu);
        (void)hipGetLastError();
        grid = cus;
    }
    if (grid < 0) return;
    if (hipMemsetAsync((char*)d_ws + WS_CTL, 0, CTL_ZERO_BYTES, stream) != hipSuccess) return;
    Args a{};
    for (int i = 0; i < 25; ++i) a.in[i] = (const float*)d_in[i];
    a.out = (float*)d_out; a.ws = (unsigned char*)d_ws;
    if (N_LAUNCHES == 1) { a.ph_lo = 0; a.ph_hi = NPH; hipLaunchKernelGGL(mk_fwd, dim3(grid), dim3(NWAVES * 64), LDS_BYTES, stream, a); }
    else { for (int p = 0; p < NPH; ++p) { a.ph_lo = p; a.ph_hi = p + 1; const int reps = (p == MK_REP_PHASE) ? 3 : 1;
            for (int r = 0; r < reps; ++r) { if (p == 9 && reps > 1) hipMemsetAsync((char*)d_ws + WS_CTL + CW_CNT * 4, 0, 32 * 256, stream);
                hipLaunchKernelGGL(mk_fwd, dim3(grid), dim3(NWAVES * 64), LDS_BYTES, stream, a); } } }
}
```
